# Optimizing an MI355X kernel written in HIP

```python
import math
import jax, jax.numpy as jnp
from jax import lax
import numpy as np

D_MODEL = 1024
BATCH = 8
SEQ = 2048
DEPTH = 1
DEC_BATCH = 32
DEC_SEQ = 4
PAST_LEN = 8192
PAGE_SIZE = 128

DIL_GROUPS = ((128, 1), (512, 4), (2048, 16))
DIL_HPG = 4
DIL_N_HEADS = DIL_HPG * len(DIL_GROUPS)
DIL_HEAD_DIM = 64
DIL_QKV_W = DIL_N_HEADS * DIL_HEAD_DIM
DIL_Q_BLOCK = 128
REL_BUCKETS = 32
REL_MAX_DIST = 2048
GDN_HEADS = 8
GDN_HEAD_DIM = 128
GDN_W = GDN_HEADS * GDN_HEAD_DIM
GDN_QKV_W = 3 * GDN_W
GDN_CONV = 4
GDN_CHUNK = 64
MEM_LEN = 256
MEM_HEADS = 4
MEM_HEAD_DIM = 128
MEM_W = MEM_HEADS * MEM_HEAD_DIM
FFN_DIM = 2816
FFN_CONV = 3
EPS = 1e-6
SPLIT_SIZES = (DIL_QKV_W, DIL_QKV_W, DIL_QKV_W, GDN_QKV_W, GDN_W, GDN_HEADS, GDN_HEADS, D_MODEL, D_MODEL)
SPLIT_IDX = tuple(int(i) for i in np.cumsum(SPLIT_SIZES)[:-1])
N_IN = sum(SPLIT_SIZES)

kernel_name = "hybrid_dilated_deltanet_decoder_step"


def rmsnorm(x, gain):
    xf = x.astype(jnp.float32)
    y = xf * lax.rsqrt(jnp.mean(xf * xf, axis=-1, keepdims=True) + EPS)
    return (y * gain.astype(jnp.float32)).astype(x.dtype)


def l2norm(x):
    return x * lax.rsqrt(jnp.sum(x * x, axis=-1, keepdims=True) + EPS)


def rel_bucket(dist):
    exact = REL_BUCKETS // 2
    d = jnp.maximum(dist, 1).astype(jnp.float32)
    large = exact + (jnp.log(d / exact) / math.log(REL_MAX_DIST / exact) * (REL_BUCKETS - exact)).astype(jnp.int32)
    return jnp.where(dist < exact, dist, jnp.minimum(large, REL_BUCKETS - 1))


def dilation_biases(rel_bias):
    biases = []
    for g, (window, dil) in enumerate(DIL_GROUPS):
        dist = dil * jnp.arange(window // dil + 1, dtype=jnp.int32)
        tab = rel_bias[rel_bucket(dist)]
        biases.append(tab[:, g * DIL_HPG:(g + 1) * DIL_HPG].T.astype(jnp.float32))
    return biases


def dilated_group_attend(q, kv, qpos, base, dil, bias):
    nk = bias.shape[-1]
    kpos = qpos[:, None] - dil * jnp.arange(nk, dtype=jnp.int32)[None, :]
    valid = kpos >= 0
    idx = jnp.clip(kpos - base, 0, kv.shape[1] - 1)
    kvg = jnp.take(kv, idx, axis=1)
    s = jnp.einsum('bqhd,bqjhd->bhqj', q, kvg[:, :, :, 0]).astype(jnp.float32) * (DIL_HEAD_DIM ** -0.5)
    s = jnp.where(valid[None, None], s + bias[None, :, None, :], -jnp.inf)
    lse = jax.nn.logsumexp(s, axis=-1)
    p = jnp.exp(s - lse[..., None]).astype(kv.dtype)
    return jnp.einsum('bhqj,bqjhd->bqhd', p, kvg[:, :, :, 1]), lse


def dilated_mixture(q, kvs, qpos, bases, biases):
    outs, lses = [], []
    for g, (_, dil) in enumerate(DIL_GROUPS):
        o, lse = dilated_group_attend(q[:, :, g], kvs[g], qpos, bases[g], dil, biases[g])
        outs.append(o)
        lses.append(lse)
    wts = jax.nn.softmax(jnp.stack(lses), axis=0)
    return jnp.einsum('gbhq,gbqhd->bqhd', wts.astype(q.dtype), jnp.stack(outs))


def dilated_prompt(q, k, v, biases):
    B, S = q.shape[:2]
    kvs = [jnp.stack([k[:, :, g], v[:, :, g]], axis=2) for g in range(len(DIL_GROUPS))]
    bases = (0,) * len(DIL_GROUPS)

    def block(start):
        qb = lax.dynamic_slice_in_dim(q, start, DIL_Q_BLOCK, axis=1)
        qpos = start + jnp.arange(DIL_Q_BLOCK, dtype=jnp.int32)
        return dilated_mixture(qb, kvs, qpos, bases, biases)

    starts = jnp.arange(S // DIL_Q_BLOCK, dtype=jnp.int32) * DIL_Q_BLOCK
    o = lax.map(block, starts)
    o = jnp.moveaxis(o, 0, 1).reshape(B, S, DIL_HPG, DIL_HEAD_DIM)
    new = [kv[:, S - min(w, S):] for kv, (w, _) in zip(kvs, DIL_GROUPS)]
    return o, new


def dilated_sample(q, k, v, caches, biases):
    T = q.shape[1]
    qpos = PAST_LEN + jnp.arange(T, dtype=jnp.int32)
    kvs, bases, new = [], [], []
    for g, buf in enumerate(caches):
        L = buf.shape[1]
        kv = jnp.concatenate([buf, jnp.stack([k[:, :, g], v[:, :, g]], axis=2)], axis=1)
        kvs.append(kv)
        bases.append(PAST_LEN - L)
        new.append(kv[:, kv.shape[1] - L:])
    return dilated_mixture(q, kvs, qpos, bases, biases), new


def causal_dwconv(x, buf, w):
    T, K = x.shape[1], w.shape[0]
    xp = jnp.concatenate([buf.astype(x.dtype), x], axis=1)
    y = xp[:, :T] * w[0]
    for j in range(1, K):
        y = y + xp[:, j:j + T] * w[j]
    return y, xp[:, T:]


def gated_delta_chunked(q, k, v, beta, g, s0):
    B, T, H, Dk = k.shape
    Dv = v.shape[-1]
    C = min(GDN_CHUNK, T)
    pad = (-T) % C
    if pad:
        pw = ((0, 0), (0, pad), (0, 0))
        q, k, v = (jnp.pad(a, pw + ((0, 0),)) for a in (q, k, v))
        beta, g = jnp.pad(beta, pw), jnp.pad(g, pw)
    N = (T + pad) // C

    def blk(a):
        return jnp.moveaxis(a.reshape((B, N, C) + a.shape[2:]), 3, 1)

    qc, kc, vc, bc, gc = (blk(a) for a in (q, k, v, beta, g))
    G = jnp.cumsum(gc, axis=-1)
    ii = jnp.arange(C)
    incl = ii[:, None] >= ii[None, :]
    strict = ii[:, None] > ii[None, :]
    gamma = jnp.exp(jnp.where(incl, G[..., :, None] - G[..., None, :], -jnp.inf))
    kk = jnp.einsum('bhnck,bhnek->bhnce', kc, kc)
    m = jnp.where(strict, bc[..., :, None] * kk * gamma, 0.0)
    rhs = jnp.concatenate([vc * bc[..., None], kc * (bc * jnp.exp(G))[..., None]], axis=-1)
    sol = lax.linalg.triangular_solve(m, rhs, left_side=True, lower=True, unit_diagonal=True)
    u0, w = sol[..., :Dv], sol[..., Dv:]
    a_intra = jnp.einsum('bhnck,bhnek->bhnce', qc, kc) * gamma
    q_dec = qc * jnp.exp(G)[..., None]
    k_dec = kc * jnp.exp(G[..., -1:] - G)[..., None]
    decay_tot = jnp.exp(G[..., -1])
    xs = tuple(jnp.moveaxis(a, 2, 0) for a in (u0, w, a_intra, q_dec, k_dec, decay_tot))

    def step(s, inp):
        u0_n, w_n, a_n, qd_n, kd_n, dt_n = inp
        v_new = u0_n - jnp.einsum('bhck,bhkv->bhcv', w_n, s)
        o_n = jnp.einsum('bhck,bhkv->bhcv', qd_n, s) + jnp.einsum('bhce,bhev->bhcv', a_n, v_new)
        s = s * dt_n[..., None, None] + jnp.einsum('bhck,bhcv->bhkv', kd_n, v_new)
        return s, o_n

    s_fin, o = lax.scan(step, s0, xs)
    o = jnp.transpose(o, (1, 0, 3, 2, 4)).reshape(B, N * C, H, Dv)[:, :T]
    return o, s_fin


def gdn_branch(qkv, z, beta_raw, a_raw, conv_buf, s0, w_conv, a_log, dt_bias, norm_out):
    B, T, _ = qkv.shape
    hs = (B, T, GDN_HEADS, GDN_HEAD_DIM)
    qkv_c, conv_new = causal_dwconv(qkv, conv_buf, w_conv)
    q, k, v = jnp.split(jax.nn.silu(qkv_c.astype(jnp.float32)), 3, axis=-1)
    q = l2norm(q.reshape(hs)) * (GDN_HEAD_DIM ** -0.5)
    k = l2norm(k.reshape(hs))
    beta = jax.nn.sigmoid(beta_raw.astype(jnp.float32))
    g = -jnp.exp(a_log.astype(jnp.float32)) * jax.nn.softplus(a_raw.astype(jnp.float32) + dt_bias.astype(jnp.float32))
    o, s_new = gated_delta_chunked(q, k, v.reshape(hs), beta, g, s0.astype(jnp.float32))
    o = rmsnorm(o, norm_out) * jax.nn.silu(z.astype(jnp.float32).reshape(hs))
    return o.reshape(B, T, GDN_W).astype(qkv.dtype), conv_new, s_new.astype(s0.dtype)


def token_mix(u, dilated_fn, conv_buf, delta_state, w_in, w_conv_delta, a_log, dt_bias, norm_delta_out,
              w_branch_a, w_branch_b, w_out):
    B, T, _ = u.shape
    qa, ka, va, qkv_b, z_b, beta_raw, a_raw, gate_a, gate_b = jnp.split(u @ w_in, SPLIT_IDX, axis=-1)
    ashape = (B, T, len(DIL_GROUPS), DIL_HPG, DIL_HEAD_DIM)
    o_a, dil_state = dilated_fn(qa.reshape(ashape), ka.reshape(ashape), va.reshape(ashape))
    o_b, conv_new, delta_new = gdn_branch(qkv_b, z_b, beta_raw, a_raw, conv_buf, delta_state, w_conv_delta,
                                          a_log, dt_bias, norm_delta_out)
    merged = (jax.nn.sigmoid(gate_a) * (o_a.reshape(B, T, DIL_HPG * DIL_HEAD_DIM) @ w_branch_a)
              + jax.nn.sigmoid(gate_b) * (o_b @ w_branch_b))
    return merged @ w_out, dil_state, conv_new, delta_new


def memory_kv(mem, norm_mem_kv, w_mem_kv):
    B, M, _ = mem.shape
    k, v = jnp.split(rmsnorm(mem, norm_mem_kv) @ w_mem_kv, 2, axis=-1)
    return k.reshape(B, M, MEM_HEADS, MEM_HEAD_DIM), v.reshape(B, M, MEM_HEADS, MEM_HEAD_DIM)


def memory_attend(u, mem_k, mem_v, w_mem_q, w_mem_o):
    B, T, _ = u.shape
    q = (u @ w_mem_q).reshape(B, T, MEM_HEADS, MEM_HEAD_DIM)
    s = jnp.einsum('bthd,bmhd->bhtm', q, mem_k.astype(q.dtype)).astype(jnp.float32) * (MEM_HEAD_DIM ** -0.5)
    p = jax.nn.softmax(s, axis=-1).astype(q.dtype)
    o = jnp.einsum('bhtm,bmhd->bthd', p, mem_v.astype(q.dtype)).reshape(B, T, MEM_W)
    return o @ w_mem_o


def conv_ffn(u, conv_buf, w_up, w_conv, b_conv, w_down):
    gate, up = jnp.split(u @ w_up, 2, axis=-1)
    gate_c, conv_new = causal_dwconv(gate, conv_buf, w_conv)
    return (jax.nn.silu(gate_c + b_conv) * up) @ w_down, conv_new


def decoder_layer(h, dilated_fn, delta_conv_buf, delta_state, mem_k, mem_v, ffn_conv_buf,
                  norm_mix, w_in, w_conv_delta, a_log, dt_bias, norm_delta_out, w_branch_a, w_branch_b, w_out,
                  norm_mem_q, w_mem_q, w_mem_o, norm_ffn, w_ffn_up, w_ffn_conv, b_ffn_conv, w_ffn_down):
    mix, dil_state, dconv_new, delta_new = token_mix(rmsnorm(h, norm_mix), dilated_fn, delta_conv_buf, delta_state,
                                                     w_in, w_conv_delta, a_log, dt_bias, norm_delta_out,
                                                     w_branch_a, w_branch_b, w_out)
    h = h + mix
    h = h + memory_attend(rmsnorm(h, norm_mem_q), mem_k, mem_v, w_mem_q, w_mem_o)
    f, fconv_new = conv_ffn(rmsnorm(h, norm_ffn), ffn_conv_buf, w_ffn_up, w_ffn_conv, b_ffn_conv, w_ffn_down)
    return h + f, dil_state, dconv_new, delta_new, fconv_new


def setup_inputs(seed: int = 0) -> dict:
    key = jax.random.key(seed)
    ks = iter(jax.random.split(key, 48))
    nrm = lambda shape, scale: scale * jax.random.normal(next(ks), shape, jnp.float32)
    gain = lambda shape: 1.0 + 0.02 * jax.random.normal(next(ks), shape, jnp.float32)
    L = DEPTH
    dl = [min(w, PAST_LEN) for w, _ in DIL_GROUPS]
    a_log = jnp.log(jax.random.uniform(next(ks), (L, GDN_HEADS), jnp.float32, 1.0, 16.0))
    dt = jnp.exp(jax.random.uniform(next(ks), (L, GDN_HEADS), jnp.float32, math.log(1e-3), math.log(1e-1)))
    dt_bias = dt + jnp.log(-jnp.expm1(-dt))
    return {
        'x_prompt': nrm((BATCH, SEQ, D_MODEL), 1.0),
        'x_sample': nrm((DEC_BATCH, DEC_SEQ, D_MODEL), 1.0),
        'cache_dil0_kv': nrm((L, DEC_BATCH, dl[0], 2, DIL_HPG, DIL_HEAD_DIM), 1.0),
        'cache_dil1_kv': nrm((L, DEC_BATCH, dl[1], 2, DIL_HPG, DIL_HEAD_DIM), 1.0),
        'cache_dil2_kv': nrm((L, DEC_BATCH, dl[2], 2, DIL_HPG, DIL_HEAD_DIM), 1.0),
        'state_delta': nrm((L, DEC_BATCH, GDN_HEADS, GDN_HEAD_DIM, GDN_HEAD_DIM), 0.1),
        'state_delta_conv': nrm((L, DEC_BATCH, GDN_CONV - 1, GDN_QKV_W), 1.0),
        'cache_mem_k': nrm((L, DEC_BATCH, MEM_LEN, MEM_HEADS, MEM_HEAD_DIM), 1.0),
        'cache_mem_v': nrm((L, DEC_BATCH, MEM_LEN, MEM_HEADS, MEM_HEAD_DIM), 1.0),
        'state_ffn_conv': nrm((L, DEC_BATCH, FFN_CONV - 1, FFN_DIM), 1.0),
        'mem_prompt': nrm((BATCH, MEM_LEN, D_MODEL), 1.0),
        'rel_bias': nrm((REL_BUCKETS, DIL_N_HEADS), 0.2),
        'norm_mix': gain((L, D_MODEL)),
        'w_in': nrm((L, D_MODEL, N_IN), D_MODEL ** -0.5),
        'w_conv_delta': nrm((L, GDN_CONV, GDN_QKV_W), GDN_CONV ** -0.5),
        'a_log': a_log,
        'dt_bias': dt_bias,
        'norm_delta_out': gain((L, GDN_HEAD_DIM)),
        'w_branch_a': nrm((L, DIL_HPG * DIL_HEAD_DIM, D_MODEL), (DIL_HPG * DIL_HEAD_DIM) ** -0.5),
        'w_branch_b': nrm((L, GDN_W, D_MODEL), GDN_W ** -0.5),
        'w_out': nrm((L, D_MODEL, D_MODEL), D_MODEL ** -0.5),
        'norm_mem_q': gain((L, D_MODEL)),
        'norm_mem_kv': gain((L, D_MODEL)),
        'w_mem_q': nrm((L, D_MODEL, MEM_W), D_MODEL ** -0.5),
        'w_mem_kv': nrm((L, D_MODEL, 2 * MEM_W), D_MODEL ** -0.5),
        'w_mem_o': nrm((L, MEM_W, D_MODEL), MEM_W ** -0.5),
        'norm_ffn': gain((L, D_MODEL)),
        'w_ffn_up': nrm((L, D_MODEL, 2 * FFN_DIM), D_MODEL ** -0.5),
        'w_ffn_conv': nrm((L, FFN_CONV, FFN_DIM), FFN_CONV ** -0.5),
        'b_ffn_conv': nrm((L, FFN_DIM), 0.02),
        'w_ffn_down': nrm((L, FFN_DIM, D_MODEL), FFN_DIM ** -0.5),
        'norm_final': gain((D_MODEL,)),
    }


def reference(x_prompt, x_sample, cache_dil0_kv, cache_dil1_kv, cache_dil2_kv, state_delta, state_delta_conv,
              cache_mem_k, cache_mem_v, state_ffn_conv, mem_prompt, rel_bias, norm_mix, w_in, w_conv_delta,
              a_log, dt_bias, norm_delta_out, w_branch_a, w_branch_b, w_out, norm_mem_q, norm_mem_kv, w_mem_q,
              w_mem_kv, w_mem_o, norm_ffn, w_ffn_up, w_ffn_conv, b_ffn_conv, w_ffn_down, norm_final):
    biases = dilation_biases(rel_bias)
    B, dt = x_prompt.shape[0], x_prompt.dtype
    zero_dconv = jnp.zeros((B, GDN_CONV - 1, GDN_QKV_W), dt)
    zero_delta = jnp.zeros((B, GDN_HEADS, GDN_HEAD_DIM, GDN_HEAD_DIM), dt)
    zero_fconv = jnp.zeros((B, FFN_CONV - 1, FFN_DIM), dt)
    h_p, h_s = x_prompt, x_sample
    p_states, s_states = [], []
    for l in range(DEPTH):
        lw = (norm_mix[l], w_in[l], w_conv_delta[l], a_log[l], dt_bias[l], norm_delta_out[l], w_branch_a[l],
              w_branch_b[l], w_out[l], norm_mem_q[l], w_mem_q[l], w_mem_o[l], norm_ffn[l], w_ffn_up[l],
              w_ffn_conv[l], b_ffn_conv[l], w_ffn_down[l])
        mk_p, mv_p = memory_kv(mem_prompt, norm_mem_kv[l], w_mem_kv[l])
        h_p, dil_p, dconv_p, delta_p, fconv_p = decoder_layer(
            h_p, lambda q, k, v: dilated_prompt(q, k, v, biases), zero_dconv, zero_delta, mk_p, mv_p, zero_fconv, *lw)
        p_states.append((dil_p[0], dil_p[1], dil_p[2], delta_p, dconv_p, mk_p, mv_p, fconv_p))
        caches_l = (cache_dil0_kv[l], cache_dil1_kv[l], cache_dil2_kv[l])
        h_s, dil_s, dconv_s, delta_s, fconv_s = decoder_layer(
            h_s, lambda q, k, v, c=caches_l: dilated_sample(q, k, v, c, biases), state_delta_conv[l],
            state_delta[l], cache_mem_k[l], cache_mem_v[l], state_ffn_conv[l], *lw)
        s_states.append((dil_s[0], dil_s[1], dil_s[2], delta_s, dconv_s, fconv_s))
    y_prompt = rmsnorm(h_p, norm_final)
    y_sample = rmsnorm(h_s, norm_final)
    (dil0_p, dil1_p, dil2_p, delta_p, dconv_p, mem_k_p, mem_v_p, fconv_p) = [jnp.stack(t, axis=0) for t in zip(*p_states)]
    (dil0_s, dil1_s, dil2_s, delta_s, dconv_s, fconv_s) = [jnp.stack(t, axis=0) for t in zip(*s_states)]
    return (y_prompt, y_sample, dil0_p, dil1_p, dil2_p, delta_p, dconv_p, mem_k_p, mem_v_p, fconv_p,
            dil0_s, dil1_s, dil2_s, delta_s, dconv_s, fconv_s)
```

```cpp
#include <hip/hip_runtime.h>
#include <cstdio>
#include <cstdint>
namespace pg8 {
#define PG8_LAS __attribute__((address_space(3)))
typedef unsigned short bf16_t;
typedef short bf16x8 __attribute__((ext_vector_type(8)));
typedef float f32x4 __attribute__((ext_vector_type(4)));
typedef unsigned u32x4 __attribute__((ext_vector_type(4)));
constexpr int BM = 256, BK = 64, HALF = 128, HTB = HALF * BK * 2  , STAGE_BYTES = 8 * HTB, NXCD = 8, WGM = 8;

__host__ __device__ __forceinline__ int lds_byte(int r, int c) { const int st = (r >> 4) * 2 + (c >> 5), rr = r & 15, cc = c & 31, ob = rr * 64 + cc * 2; return st * 1024 + (ob ^ (((ob >> 9) & 1) << 5)); }
__host__ __device__ __forceinline__ void stage_rc(int b, int& R, int& C) { const int st = b / 1024, sb = b % 1024, swz = sb ^ (((sb >> 9) & 1) << 5); R = (st >> 1) * 16 + swz / 64; C = (st & 1) * 32 + (swz % 64) / 2; }
__host__ __device__ __forceinline__ int perm32(int rho) { const int n = rho >> 4, i = rho & 15; return 8 * (i >> 2) + 4 * n + (i & 3); }

struct Unit { int pm, pn; };
struct Gemm { const bf16_t* A; const bf16_t* Bt; int M, N, K; };

struct StaticOrder {
    int nM, nN, nwg, G, c;
    __host__ __device__ void init(int M, int N, int G_, int c_) { nM = M / BM; nN = N / BM; nwg = nM * nN; G = G_; c = c_; }
    __host__ __device__ bool next(int i, Unit& u) const {
        const long L = (long)i * G + c; if (L >= nwg) return false;
        int wgid = (int)L; { const int q = nwg / NXCD, r = nwg % NXCD, xcd = wgid % NXCD, off = wgid / NXCD; wgid = (xcd < r ? xcd * (q + 1) : r * (q + 1) + (xcd - r) * q) + off; }
        const int nig = WGM * nN, gid = wgid / nig, fm = gid * WGM, gsz = (nM - fm) < WGM ? (nM - fm) : WGM;
        u.pm = fm + ((wgid % nig) % gsz); u.pn = (wgid % nig) / gsz; return true;
    }
    __device__ __forceinline__ void a_ready(const Unit&) const {}
    __device__ __forceinline__ void done(const Unit&) const {}
};
template <class Epi, class Sched, bool ALIGN_EPI = false, bool SP2 = false>
__device__ __forceinline__ void gemm_phase(PG8_LAS unsigned char* lds, const Gemm g, const Sched& S, const Epi& E) {
    int tid_ = threadIdx.x; asm volatile("" : "+v"(tid_));
    const int tid = tid_, wid = __builtin_amdgcn_readfirstlane(tid >> 6), lane = tid & 63, wr = wid >> 2, wc = wid & 3, fr = lane & 15, fq = lane >> 4;
    const int K = g.K, nt = K / BK;
    unsigned voffA[2], voffB[2];
#pragma unroll
    for (int i = 0; i < 2; ++i) { int R, C; stage_rc(tid * 16 + i * 8192, R, C); const int Rb = Epi::PERM ? ((R & ~31) + perm32(R & 31)) : R;
        voffA[i] = (unsigned)(R * K + C) * 2u; voffB[i] = (unsigned)(Rb * K + C) * 2u; }
    const size_t kstep = (size_t)(BK * 2);
    const size_t hstep = (size_t)HALF * K * 2;
    const size_t tstep = 2 * hstep;
    const unsigned ldsw = (unsigned)wid * 1024u;
    const int aoff = lds_byte(wr * 64 + fr, fq * 8), boff = lds_byte(wc * 32 + fr, fq * 8);
#define PG8_SA(b, h) (((b) * 2 + (h)) * HTB)
#define PG8_SB(b, h) ((4 + (b) * 2 + (h)) * HTB)
#define PG8_STAGE(bufoff, gbase, voff) do { _Pragma("unroll") for (int _i = 0; _i < 2; ++_i) \
        __builtin_amdgcn_global_load_lds((const unsigned*)((const char*)(gbase) + (voff)[_i]), (PG8_LAS unsigned*)(lds + (bufoff) + ldsw + _i * 8192), 16, 0, 0); } while (0)
#define PG8_LDA(dst, b, h) do { _Pragma("unroll") for (int m = 0; m < 4; ++m) _Pragma("unroll") for (int k = 0; k < 2; ++k) dst[m][k] = *(const PG8_LAS bf16x8*)(lds + PG8_SA(b, h) + aoff + m * 2048 + k * 1024); } while (0)
#define PG8_LDB(dst, b, h) do { _Pragma("unroll") for (int n = 0; n < 2; ++n) _Pragma("unroll") for (int k = 0; k < 2; ++k) dst[n][k] = *(const PG8_LAS bf16x8*)(lds + PG8_SB(b, h) + boff + n * 2048 + k * 1024); } while (0)
#define PG8_MMA(ai, bj, At, Bt) do { __builtin_amdgcn_s_setprio(1); _Pragma("unroll") for (int m = 0; m < 4; ++m) _Pragma("unroll") for (int n = 0; n < 2; ++n) _Pragma("unroll") for (int k = 0; k < 2; ++k) \
        acc[ai][bj][m][n] = __builtin_amdgcn_mfma_f32_16x16x32_bf16(Bt[n][k], At[m][k], acc[ai][bj][m][n], 0, 0, 0); __builtin_amdgcn_s_setprio(0); } while (0)
#define PG8_WAIT_V(n) asm volatile("s_waitcnt vmcnt(" #n ")" ::: "memory")
#define PG8_WAIT_L(n) asm volatile("s_waitcnt lgkmcnt(" #n ")" ::: "memory")
#define PG8_BAR __builtin_amdgcn_s_barrier()
#define PG8_SCHED __builtin_amdgcn_sched_barrier(0)
    Unit cur, nxt; int ui = 0;
    if (!S.next(0, cur)) return;
    f32x4 acc[2][2][4][2];
#pragma unroll
    for (int a = 0; a < 2; ++a)
#pragma unroll
        for (int b = 0; b < 2; ++b)
#pragma unroll
            for (int m = 0; m < 4; ++m)
#pragma unroll
                for (int n = 0; n < 2; ++n) acc[a][b][m][n] = (f32x4){0.f, 0.f, 0.f, 0.f};
    bf16x8 At[4][2], B0[2][2], B1[2][2];
    const char* cA = (const char*)g.A + (size_t)cur.pm * tstep; const char* cB = (const char*)g.Bt + (size_t)cur.pn * tstep;
    S.a_ready(cur);
    if constexpr (SP2) {
        PG8_STAGE(PG8_SB(0, 0), cB, voffB); PG8_STAGE(PG8_SB(0, 1), cB + hstep, voffB); PG8_STAGE(PG8_SA(0, 0), cA, voffA); PG8_STAGE(PG8_SA(0, 1), cA + hstep, voffA);
        if (wr == 1) PG8_BAR;
        PG8_WAIT_V(2); PG8_BAR;
        PG8_STAGE(PG8_SB(1, 0), cB + kstep, voffB); PG8_STAGE(PG8_SA(1, 0), cA + kstep, voffA); PG8_STAGE(PG8_SB(1, 1), cB + hstep + kstep, voffB);
        PG8_WAIT_V(6); PG8_BAR;
    } else {
        PG8_STAGE(PG8_SB(0, 0), cB, voffB); PG8_STAGE(PG8_SA(0, 0), cA, voffA); PG8_STAGE(PG8_SB(0, 1), cB + hstep, voffB); PG8_STAGE(PG8_SA(0, 1), cA + hstep, voffA);
        if (wr == 1) PG8_BAR;
        PG8_WAIT_V(4); PG8_BAR;
        PG8_STAGE(PG8_SB(1, 0), cB + kstep, voffB); PG8_STAGE(PG8_SA(1, 0), cA + kstep, voffA); PG8_STAGE(PG8_SB(1, 1), cB + hstep + kstep, voffB);
        PG8_WAIT_V(6); PG8_BAR;
    }
    for (;;) {
        const bool has_next = S.next(ui + 1, nxt);
        const char* nA = has_next ? (const char*)g.A + (size_t)nxt.pm * tstep : cA; const char* nB = has_next ? (const char*)g.Bt + (size_t)nxt.pn * tstep : cB;
        for (int t = 0; t < nt; t += 2) {
            const bool last = (t == nt - 2);
            const char* a1 = cA + (size_t)(t + 1) * kstep;
            const char* a2 = last ? nA : cA + (size_t)(t + 2) * kstep; const char* b2 = last ? nB : cB + (size_t)(t + 2) * kstep;
            const char* a3 = a2 + kstep; const char* b3 = b2 + kstep;
            if (last && has_next) S.a_ready(nxt);
            if constexpr (SP2) {
            PG8_LDB(B0, 0, 0); PG8_LDB(B1, 0, 1); PG8_SCHED; PG8_LDA(At, 0, 0); PG8_STAGE(PG8_SA(1, 1), a1 + hstep, voffA);
            PG8_WAIT_V(8); PG8_WAIT_L(0); PG8_BAR; PG8_MMA(0, 0, At, B0); PG8_MMA(0, 1, At, B1); PG8_BAR; PG8_SCHED;
            PG8_LDA(At, 0, 1); PG8_STAGE(PG8_SB(0, 0), b2, voffB); PG8_STAGE(PG8_SB(0, 1), b2 + hstep, voffB); PG8_STAGE(PG8_SA(0, 0), a2, voffA);
            PG8_WAIT_V(8); PG8_WAIT_L(0); PG8_BAR; PG8_MMA(1, 0, At, B0); PG8_MMA(1, 1, At, B1); PG8_BAR; PG8_SCHED;
            PG8_LDB(B0, 1, 0); PG8_LDB(B1, 1, 1); PG8_SCHED; PG8_LDA(At, 1, 0); PG8_STAGE(PG8_SA(0, 1), a2 + hstep, voffA);
            PG8_WAIT_V(8); PG8_WAIT_L(0); PG8_BAR; PG8_MMA(0, 0, At, B0); PG8_MMA(0, 1, At, B1); PG8_BAR; PG8_SCHED;
            PG8_LDA(At, 1, 1); PG8_STAGE(PG8_SB(1, 0), b3, voffB); PG8_STAGE(PG8_SB(1, 1), b3 + hstep, voffB); PG8_STAGE(PG8_SA(1, 0), a3, voffA);
            PG8_WAIT_V(8); PG8_WAIT_L(0); PG8_BAR; PG8_MMA(1, 0, At, B0); PG8_MMA(1, 1, At, B1); PG8_BAR; PG8_SCHED;
            } else {
            PG8_LDB(B0, 0, 0); PG8_SCHED; PG8_LDA(At, 0, 0); PG8_STAGE(PG8_SA(1, 1), a1 + hstep, voffA);
            PG8_WAIT_L(8); PG8_BAR; PG8_WAIT_L(0); PG8_MMA(0, 0, At, B0); PG8_BAR; PG8_SCHED;
            PG8_LDB(B1, 0, 1); PG8_STAGE(PG8_SB(0, 0), b2, voffB);
            PG8_BAR; PG8_WAIT_L(0); PG8_MMA(0, 1, At, B1); PG8_BAR;
            PG8_LDA(At, 0, 1); PG8_STAGE(PG8_SA(0, 0), a2, voffA);
            PG8_BAR; PG8_WAIT_L(0); PG8_MMA(1, 0, At, B0); PG8_BAR; PG8_SCHED;
            PG8_STAGE(PG8_SB(0, 1), b2 + hstep, voffB);
            PG8_WAIT_V(6); PG8_BAR; PG8_MMA(1, 1, At, B1); PG8_BAR;
            PG8_LDB(B0, 1, 0); PG8_SCHED; PG8_LDA(At, 1, 0); PG8_STAGE(PG8_SA(0, 1), a2 + hstep, voffA);
            PG8_WAIT_L(8); PG8_BAR; PG8_WAIT_L(0); PG8_MMA(0, 0, At, B0); PG8_BAR; PG8_SCHED;
            PG8_LDB(B1, 1, 1); PG8_STAGE(PG8_SB(1, 0), b3, voffB);
            PG8_BAR; PG8_WAIT_L(0); PG8_MMA(0, 1, At, B1); PG8_BAR;
            PG8_LDA(At, 1, 1); PG8_STAGE(PG8_SA(1, 0), a3, voffA);
            PG8_BAR; PG8_WAIT_L(0); PG8_MMA(1, 0, At, B0); PG8_BAR; PG8_SCHED;
            PG8_STAGE(PG8_SB(1, 1), b3 + hstep, voffB);
            PG8_WAIT_V(6); PG8_BAR; PG8_MMA(1, 1, At, B1); PG8_BAR;
            }
        }
        if constexpr (ALIGN_EPI) { if (wr == 0) PG8_BAR; }
        if constexpr (!Epi::AFTER_DRAIN) { E(acc, cur, wr, wc, fr, fq); S.done(cur); }
        if (!has_next) break;
#pragma unroll
        for (int a = 0; a < 2; ++a)
#pragma unroll
            for (int b = 0; b < 2; ++b)
#pragma unroll
                for (int m = 0; m < 4; ++m)
#pragma unroll
                    for (int n = 0; n < 2; ++n) acc[a][b][m][n] = (f32x4){0.f, 0.f, 0.f, 0.f};
        cur = nxt; cA = nA; cB = nB; ++ui;
        if constexpr (ALIGN_EPI) { if (wr == 1) PG8_BAR; }
    }
    PG8_WAIT_V(0);
    if constexpr (!ALIGN_EPI) { if (wr == 0) PG8_BAR; }
    PG8_BAR;
    if constexpr (Epi::AFTER_DRAIN) { E.fused(acc, cur, wr, wc, fr, fq, lds, wid, lane); S.done(cur); }
#undef PG8_SA
#undef PG8_SB
#undef PG8_STAGE
#undef PG8_LDA
#undef PG8_LDB
#undef PG8_MMA
#undef PG8_WAIT_V
#undef PG8_WAIT_L
#undef PG8_BAR
#undef PG8_SCHED
}
}

#define LAS __attribute__((address_space(3)))
#define GAS __attribute__((address_space(1)))
namespace mk {
typedef unsigned short bf16_t;
typedef short bf16x8 __attribute__((ext_vector_type(8)));
typedef float f32x4 __attribute__((ext_vector_type(4)));
typedef unsigned u32x4 __attribute__((ext_vector_type(4)));
typedef unsigned u32x2 __attribute__((ext_vector_type(2)));
typedef GAS unsigned gu32;

constexpr int NWAVES = 8, NTHR = 512;
constexpr int D = 1024, NB = 8, SEQ = 2048, MP = NB * SEQ, SB = 32, ST = 4, MS = SB * ST, MV = MP + MS, MT = 16640;
constexpr int NPA = 5376, NPB = 3328, NIN = 8704, FF = 2816, NUP = 2 * FF;
constexpr int PA_QA = 0, PA_KA = 768, PA_VA = 1536, PA_QB = 2304;
constexpr int PB_Z = 0, PB_GA = 1024, PB_GB = 2048, PB_BETA = 3072, PB_A = 3080;
constexpr int PAST = 8192;
constexpr float EPS = 1e-6f;

constexpr size_t O_Y = 0;
constexpr size_t O_YS = O_Y + (size_t)MP * D;
constexpr size_t O_DIL0P = O_YS + (size_t)MS * D;
constexpr size_t O_DIL1P = O_DIL0P + (size_t)NB * 128 * 512;
constexpr size_t O_DIL2P = O_DIL1P + (size_t)NB * 512 * 512;
constexpr size_t O_DSTP = O_DIL2P + (size_t)NB * 2048 * 512;
constexpr size_t O_DCONVP = O_DSTP + (size_t)NB * 8 * 128 * 128;
constexpr size_t O_MEMKP = O_DCONVP + (size_t)NB * 3 * 3072;
constexpr size_t O_MEMVP = O_MEMKP + (size_t)NB * 256 * 512;
constexpr size_t O_FCONVP = O_MEMVP + (size_t)NB * 256 * 512;
constexpr size_t O_DIL0S = O_FCONVP + (size_t)NB * 2 * FF;
constexpr size_t O_DIL1S = O_DIL0S + (size_t)SB * 128 * 512;
constexpr size_t O_DIL2S = O_DIL1S + (size_t)SB * 512 * 512;
constexpr size_t O_DSTS = O_DIL2S + (size_t)SB * 2048 * 512;
constexpr size_t O_DCONVS = O_DSTS + (size_t)SB * 8 * 128 * 128;
constexpr size_t O_FCONVS = O_DCONVS + (size_t)SB * 3 * 3072;
constexpr size_t O_END = O_FCONVS + (size_t)SB * 2 * FF;

constexpr size_t MiB = 1u << 20;
constexpr size_t WS_CTL = 0, CTL_ZERO_BYTES = 1 * MiB;
constexpr size_t WS_WIN = 1 * MiB;
constexpr size_t WS_WA = WS_WIN + (size_t)NIN * D * 2;
constexpr size_t WS_WB = WS_WA + (size_t)D * 256 * 2;
constexpr size_t WS_WOUT = WS_WB + (size_t)D * D * 2;
constexpr size_t WS_WMQ = WS_WOUT + (size_t)D * D * 2;
constexpr size_t WS_WMKV = WS_WMQ + (size_t)512 * D * 2;
constexpr size_t WS_WMO = WS_WMKV + (size_t)D * D * 2;
constexpr size_t WS_WUP = WS_WMO + (size_t)D * 512 * 2;
constexpr size_t WS_WDN = WS_WUP + (size_t)NUP * D * 2;
constexpr size_t WS_XN = WS_WDN + (size_t)D * FF * 2;
constexpr size_t WS_MN = WS_XN + (size_t)MT * D * 2;
constexpr size_t WS_MEMKV = WS_MN + (size_t)2048 * D * 2;
constexpr size_t WS_LSE = WS_MEMKV + (size_t)2048 * D * 2;
constexpr size_t WS_BIAS = WS_LSE + (size_t)3 * MP * 4 * 4;
constexpr size_t WS_OA = WS_BIAS + 8192;
constexpr size_t WS_R1 = WS_OA + (size_t)MT * 256 * 2;
constexpr size_t WS_R2 = WS_R1 + (size_t)MT * NPA * 2;
constexpr size_t WS_R3 = WS_R2 + (size_t)MT * NPB * 2;
constexpr size_t CH_STRIDE = 66560;
constexpr size_t WS_END = WS_R3 + (size_t)2048 * CH_STRIDE;
constexpr size_t WS_HB = WS_R3;
constexpr size_t WS_T1 = WS_HB + (size_t)MT * D * 2;
constexpr size_t WS_QM = WS_T1 + (size_t)MT * D * 2;
constexpr size_t WS_OM = WS_QM + (size_t)MT * 512 * 2;
constexpr size_t WS_ACT = WS_T1;
constexpr size_t WS_GU = WS_R1;
static_assert(WS_END <= 512 * MiB, "workspace map exceeds the guaranteed 512 MiB");
static_assert(WS_OM + (size_t)MT * 512 * 2 <= WS_END && WS_ACT + (size_t)MT * FF * 2 <= WS_END, "R3 overlay");
static_assert(WS_GU + (size_t)MT * NUP * 2 <= WS_R3, "GU spans R1+R2");
static_assert(WS_XN % 256 == 0 && WS_R1 % 256 == 0 && WS_R2 % 256 == 0 && WS_R3 % 256 == 0 && WS_OA % 256 == 0, "alignment");
constexpr int CW_Q0 = 64, CW_Q1 = 128, CW_Q2 = 192;
constexpr int CW_BAR = 4096;
constexpr size_t CTL_SSQ1 = 64 * 1024, CTL_SSQ2 = 192 * 1024;

constexpr int RING_BYTES = 147456;
constexpr int LDSCTL_OFF = RING_BYTES, MISC_OFF = LDSCTL_OFF + 64;
constexpr int LDS_BYTES = RING_BYTES + 512;

#define LDS_WAIT() asm volatile("s_waitcnt lgkmcnt(0)" ::: "memory")
#define VM_WAIT() asm volatile("s_waitcnt vmcnt(0)" ::: "memory")
#define RLX_AGENT __ATOMIC_RELAXED, __HIP_MEMORY_SCOPE_AGENT

typedef float f32x2_ __attribute__((ext_vector_type(2)));
typedef __bf16 bf16x2_ __attribute__((ext_vector_type(2)));
__device__ __forceinline__ unsigned cvt_pk_bf16(float lo, float hi) { const f32x2_ v = {lo, hi}; const bf16x2_ b = __builtin_convertvector(v, bf16x2_); return __builtin_bit_cast(unsigned, b); }
__device__ __forceinline__ float bf_lo(unsigned w) { return __uint_as_float(w << 16); }
__device__ __forceinline__ float bf_hi(unsigned w) { return __uint_as_float(w & 0xffff0000u); }
__device__ __forceinline__ float bf2f(bf16_t h) { return __uint_as_float((unsigned)h << 16); }
__device__ __forceinline__ bf16_t f2bf(float f) { const __bf16 b = (__bf16)f; return __builtin_bit_cast(bf16_t, b); }
__device__ __forceinline__ u32x4 pack8(const f32x4 a, const f32x4 b) { u32x4 w; w.x = cvt_pk_bf16(a[0], a[1]); w.y = cvt_pk_bf16(a[2], a[3]); w.z = cvt_pk_bf16(b[0], b[1]); w.w = cvt_pk_bf16(b[2], b[3]); return w; }
__device__ __forceinline__ void unpack8(const u32x4 w, float (&f)[8]) { f[0] = bf_lo(w.x); f[1] = bf_hi(w.x); f[2] = bf_lo(w.y); f[3] = bf_hi(w.y); f[4] = bf_lo(w.z); f[5] = bf_hi(w.z); f[6] = bf_lo(w.w); f[7] = bf_hi(w.w); }
__device__ __forceinline__ float sigmoidf_(float x) { return __builtin_amdgcn_rcpf(1.f + __expf(-x)); }
__device__ __forceinline__ float siluf_(float x) { return x * __builtin_amdgcn_rcpf(1.f + __expf(-x)); }
__device__ __forceinline__ float wave_sum(float v) {
#pragma unroll
    for (int o = 1; o < 64; o <<= 1) v += __shfl_xor(v, o);
    return v;
}
__device__ __forceinline__ float wave_max(float v) {
#pragma unroll
    for (int o = 1; o < 64; o <<= 1) v = fmaxf(v, __shfl_xor(v, o));
    return v;
}

struct EpiProj {
    static constexpr bool PERM = true, AFTER_DRAIN = false;
    bf16_t* pa; bf16_t* pb;
    __device__ __forceinline__ void operator()(const f32x4 (&acc)[2][2][4][2], const pg8::Unit& u, int wr, int wc, int fr, int fq) const {
        const int colt = u.pn * 256; bf16_t* base; int ldc, c0;
        if (colt < NPA) { base = pa; ldc = NPA; c0 = colt; } else { base = pb; ldc = NPB; c0 = colt - NPA; }
        const int row0 = u.pm * 256 + wr * 64 + fr, col0 = c0 + wc * 32 + 8 * fq;
#pragma unroll
        for (int ai = 0; ai < 2; ++ai)
#pragma unroll
            for (int m = 0; m < 4; ++m) { bf16_t* rowp = base + (size_t)(row0 + ai * 128 + m * 16) * ldc + col0;
#pragma unroll
                for (int bj = 0; bj < 2; ++bj) *(u32x4*)(rowp + bj * 128) = pack8(acc[ai][bj][m][0], acc[ai][bj][m][1]); }
    }
};
struct EpiMemKV {
    static constexpr bool PERM = true, AFTER_DRAIN = false;
    bf16_t* O; float* kout; float* vout;
    __device__ __forceinline__ void operator()(const f32x4 (&acc)[2][2][4][2], const pg8::Unit& u, int wr, int wc, int fr, int fq) const {
        asm volatile("" : "+v"(fr), "+v"(fq));
        const int row0 = u.pm * 256 + wr * 64 + fr, col0 = u.pn * 256 + wc * 32 + 8 * fq;
#pragma unroll
        for (int ai = 0; ai < 2; ++ai)
#pragma unroll
            for (int m = 0; m < 4; ++m) { const int row = row0 + ai * 128 + m * 16;
#pragma unroll
                for (int bj = 0; bj < 2; ++bj) { const int col = col0 + bj * 128; const f32x4 v0 = acc[ai][bj][m][0], v1 = acc[ai][bj][m][1];
                    *(u32x4*)(O + (size_t)row * 1024 + col) = pack8(v0, v1);
                    float* dst = col < 512 ? kout + (size_t)row * 512 + col : vout + (size_t)row * 512 + (col - 512);
                    *(f32x4*)dst = v0; *(f32x4*)(dst + 4) = v1; } }
    }
};
template <bool SECOND> struct EpiBranch {
    static constexpr bool PERM = true, AFTER_DRAIN = false;
    bf16_t* T1; const bf16_t* pb;
    __device__ __forceinline__ void operator()(const f32x4 (&acc)[2][2][4][2], const pg8::Unit& u, int wr, int wc, int fr, int fq) const {
        asm volatile("" : "+v"(fr), "+v"(fq));
        const int row0 = u.pm * 256 + wr * 64 + fr, col0 = u.pn * 256 + wc * 32 + 8 * fq;
#pragma unroll
        for (int ai = 0; ai < 2; ++ai)
#pragma unroll
            for (int m = 0; m < 4; ++m) { const int row = row0 + ai * 128 + m * 16;
#pragma unroll
                for (int bj = 0; bj < 2; ++bj) { const int col = col0 + bj * 128;
                    const u32x4 gw = *(const u32x4*)(pb + (size_t)row * NPB + (SECOND ? PB_GB : PB_GA) + col); float g[8]; unpack8(gw, g);
                    f32x4 v0 = acc[ai][bj][m][0], v1 = acc[ai][bj][m][1];
#pragma unroll
                    for (int e = 0; e < 4; ++e) { v0[e] *= sigmoidf_(g[e]); v1[e] *= sigmoidf_(g[4 + e]); }
                    bf16_t* tp = T1 + (size_t)row * D + col;
                    if (SECOND) { const u32x4 tw = *(const u32x4*)tp; float t[8]; unpack8(tw, t);
#pragma unroll
                        for (int e = 0; e < 4; ++e) { v0[e] += t[e]; v1[e] += t[4 + e]; } }
                    *(u32x4*)tp = pack8(v0, v1); }
                asm volatile("" ::: "memory"); }
    }
};
template <bool FROM_X, bool WBF, bool SSQ> struct EpiResid {
    static constexpr bool PERM = true, AFTER_DRAIN = false;
    const float* xp; const float* xs; float* H; bf16_t* HB; float* ssq;
    __device__ __forceinline__ void operator()(const f32x4 (&acc)[2][2][4][2], const pg8::Unit& u, int wr, int wc, int fr, int fq) const {
        asm volatile("" : "+v"(fr), "+v"(fq));
        const int row0 = u.pm * 256 + wr * 64 + fr, col0 = u.pn * 256 + wc * 32 + 8 * fq;
#pragma unroll
        for (int ai = 0; ai < 2; ++ai)
#pragma unroll
            for (int m = 0; m < 4; ++m) { const int row = row0 + ai * 128 + m * 16; const bool valid = row < MV; float part = 0.f;
                const float* src = FROM_X ? (row < MP ? xp + (size_t)row * D : xs + (size_t)(row - MP) * D) : H + (size_t)row * D;
#pragma unroll
                for (int bj = 0; bj < 2; ++bj) { const int col = col0 + bj * 128;
                    f32x4 v0 = acc[ai][bj][m][0], v1 = acc[ai][bj][m][1];
                    if (valid) { v0 += *(const f32x4*)(src + col); v1 += *(const f32x4*)(src + col + 4);
                        *(f32x4*)(H + (size_t)row * D + col) = v0; *(f32x4*)(H + (size_t)row * D + col + 4) = v1; }
                    else { v0 = (f32x4){0.f, 0.f, 0.f, 0.f}; v1 = v0; }
                    if (WBF) *(u32x4*)(HB + (size_t)row * D + col) = pack8(v0, v1);
                    if (SSQ) part += (v0[0] * v0[0] + v0[1] * v0[1]) + (v0[2] * v0[2] + v0[3] * v0[3]) + (v1[0] * v1[0] + v1[1] * v1[1]) + (v1[2] * v1[2] + v1[3] * v1[3]); }
                if (SSQ) { part += __shfl_xor(part, 16); part += __shfl_xor(part, 32); if (fq == 0 && valid) atomicAdd(ssq + row, part); } }
    }
};
struct EpiScale {
    static constexpr bool PERM = true, AFTER_DRAIN = false;
    bf16_t* O; int ldc; const float* ssq;
    __device__ __forceinline__ void operator()(const f32x4 (&acc)[2][2][4][2], const pg8::Unit& u, int wr, int wc, int fr, int fq) const {
        asm volatile("" : "+v"(fr), "+v"(fq));
        const int row0 = u.pm * 256 + wr * 64 + fr, col0 = u.pn * 256 + wc * 32 + 8 * fq;
#pragma unroll
        for (int ai = 0; ai < 2; ++ai)
#pragma unroll
            for (int m = 0; m < 4; ++m) { const int row = row0 + ai * 128 + m * 16; const float rs = rsqrtf(ssq[row] * (1.f / D) + EPS);
#pragma unroll
                for (int bj = 0; bj < 2; ++bj) *(u32x4*)(O + (size_t)row * ldc + col0 + bj * 128) = pack8(acc[ai][bj][m][0] * rs, acc[ai][bj][m][1] * rs); }
    }
};
#define XB_TMO      128
#define XB_XCNT(j)  (256  + 64 * (j))
#define XB_XSUB(j)  (1280 + 64 * (j))
#define XB_XGEN(j)  (2304 + 64 * (j))
#define XB_TOP      3328
#define XB_TOPGEN   3392
#define XCD_BAR_WORDS 3456
#define XB_SPIN_CAP (1u << 22)

__device__ __forceinline__ unsigned xb_ld(unsigned* p)              { return __hip_atomic_load(p, __ATOMIC_RELAXED, __HIP_MEMORY_SCOPE_AGENT); }
__device__ __forceinline__ unsigned xb_add(unsigned* p, unsigned v) { return __hip_atomic_fetch_add(p, v, __ATOMIC_RELAXED, __HIP_MEMORY_SCOPE_AGENT); }
__device__ __forceinline__ unsigned xb_xcc_id() { return (unsigned)__builtin_amdgcn_s_getreg((3 << 11) | 20) & 0xFu; }
#define XB_SPIN(cond, bar) do { unsigned _sp = 0; while (cond) { __builtin_amdgcn_s_sleep(1); \
    if ((++_sp & 255u) == 0u) { if (xb_ld(&(bar)[XB_TMO])) break; if (_sp > XB_SPIN_CAP) { atomicAdd(&(bar)[XB_TMO], 1u); break; } } } } while (0)

struct XcdBarrier {
    unsigned* bar; unsigned x;
    volatile LAS unsigned* st;
};

__device__ __forceinline__ XcdBarrier xcd_barrier_post(unsigned* bar, volatile LAS unsigned* st) {
    XcdBarrier b; b.bar = bar; b.x = xb_xcc_id(); b.st = st;
    if (threadIdx.x == 0) (void)xb_add(&bar[XB_XCNT(b.x)], 1u);
    return b;
}
__device__ __forceinline__ void xcd_barrier_complete(unsigned* bar, unsigned x, unsigned& nloc, unsigned& nx) {
    const unsigned G = gridDim.x * gridDim.y * gridDim.z;
    unsigned sum, cnt, mine, sp = 0u;
    for (;;) {
        sum = 0u; cnt = 0u; mine = 0u;
#pragma unroll
        for (unsigned j = 0; j < 16; ++j) { const unsigned c = xb_ld(&bar[XB_XCNT(j)]); sum += c; cnt += (c > 0u) ? 1u : 0u; mine = (j == x) ? c : mine; }
        if (sum == G) break;
        __builtin_amdgcn_s_sleep(1);
        if ((++sp & 255u) == 0u) { if (xb_ld(&bar[XB_TMO])) break; if (sp > XB_SPIN_CAP) { atomicAdd(&bar[XB_TMO], 1u); break; } }
    }
    nloc = mine > 0u ? mine : 1u; nx = cnt > 0u ? cnt : 1u;
}

__device__ __forceinline__ void xcd_barrier(const XcdBarrier& b) {
    asm volatile("s_waitcnt vmcnt(0)" ::: "memory");
    __syncthreads();
    if (threadIdx.x == 0) {
        unsigned* bar = b.bar;
        __builtin_amdgcn_s_waitcnt(0);
        unsigned nloc = b.st[0], nx = b.st[1];
        if (nloc == 0u) { xcd_barrier_complete(bar, b.x, nloc, nx); b.st[0] = nloc; b.st[1] = nx; }
        const unsigned old = xb_add(&bar[XB_XSUB(b.x)], 1u);
        const unsigned gen = old / nloc;
        if (old + 1u == (gen + 1u) * nloc) {
            __builtin_amdgcn_fence(__ATOMIC_RELEASE, "agent");
            asm volatile("s_waitcnt vmcnt(0)" ::: "memory");
            const unsigned og = xb_add(&bar[XB_TOP], 1u);
            const unsigned tg = og / nx;
            if (og + 1u == (tg + 1u) * nx) xb_add(&bar[XB_TOPGEN], 1u);
            else XB_SPIN(xb_ld(&bar[XB_TOPGEN]) == tg, bar);
            __builtin_amdgcn_fence(__ATOMIC_ACQUIRE, "agent");
            xb_add(&bar[XB_XGEN(b.x)], 1u);
            asm volatile("s_waitcnt vmcnt(0)" ::: "memory");
        } else {
            XB_SPIN(xb_ld(&bar[XB_XGEN(b.x)]) == gen, bar);
            __builtin_amdgcn_fence(__ATOMIC_ACQUIRE, "agent");
            asm volatile("s_waitcnt vmcnt(0)" ::: "memory");
        }
    }
    __syncthreads();
}

struct Ctx {
    LAS unsigned char* lds; volatile LAS unsigned* MISC;
    int tid, lane, wave, G, gw, NGW, gtid, NGT;
    float* out; unsigned char* ws; unsigned* ctl;
};
struct Args { const float* in[32]; float* out; unsigned char* ws; int ph_lo, ph_hi, li, pad; };
typedef const __attribute__((address_space(4))) Args CArgs;
#define MK_IN(i) (A->in[i])
template <class T> __device__ __forceinline__ T* wsp(const Ctx& C, size_t off) { return (T*)(C.ws + off); }

__device__ __forceinline__ int next_unit(const Ctx& C, int cw) {
    __syncthreads();
    if (C.tid == 0) C.MISC[4] = __hip_atomic_fetch_add(C.ctl + cw, 1u, RLX_AGENT);
    __syncthreads();
    return (int)C.MISC[4];
}

__device__ __forceinline__ void tr_item(const float* W, int ldw, int k0, int nsrc0, int nvalid, bf16_t* WT, int ldt, int ndst0, const float* gain, LAS float* scr, int lane) {
    const int n_ = lane & 31;
#pragma unroll 8
    for (int i = 0; i < 32; ++i) { const int kk = 2 * i + (lane >> 5); float v = (n_ < nvalid) ? W[(size_t)(k0 + kk) * ldw + nsrc0 + n_] : 0.f; if (gain) v *= gain[k0 + kk]; scr[kk * 33 + n_] = v; }
    LDS_WAIT(); asm volatile("" ::: "memory");
    const int c = lane & 7;
#pragma unroll
    for (int j = 0; j < 4; ++j) { const int n = (lane >> 3) + 8 * j; const LAS float* s = scr + (8 * c) * 33 + n;
        u32x4 o; o.x = cvt_pk_bf16(s[0 * 33], s[1 * 33]); o.y = cvt_pk_bf16(s[2 * 33], s[3 * 33]); o.z = cvt_pk_bf16(s[4 * 33], s[5 * 33]); o.w = cvt_pk_bf16(s[6 * 33], s[7 * 33]);
        *(u32x4*)(WT + (size_t)(ndst0 + n) * ldt + k0 + 8 * c) = o; }
    LDS_WAIT(); asm volatile("" ::: "memory");
}
__device__ __forceinline__ void rms_row_bf16(const float* xrow, const float* gain, bf16_t* orow, int lane) {
    const f32x4* xr = (const f32x4*)xrow + lane; const f32x4* gr = (const f32x4*)gain + lane;
    f32x4 v[4]; float s = 0.f;
#pragma unroll
    for (int j = 0; j < 4; ++j) { v[j] = xr[64 * j]; s += (v[j].x * v[j].x + v[j].y * v[j].y) + (v[j].z * v[j].z + v[j].w * v[j].w); }
    const float rs = rsqrtf(wave_sum(s) * (1.f / D) + EPS);
    u32x2* o8 = (u32x2*)orow + lane;
#pragma unroll
    for (int j = 0; j < 4; ++j) { const f32x4 g = gr[64 * j]; u32x2 w; w.x = cvt_pk_bf16(v[j].x * rs * g.x, v[j].y * rs * g.y); w.y = cvt_pk_bf16(v[j].z * rs * g.z, v[j].w * rs * g.w); o8[64 * j] = w; }
}
__device__ __forceinline__ int rel_bucket(int dist) {
    if (dist < 16) return dist;
    const float dd = (float)dist;
    int large = 16 + (int)(logf(dd / 16.f) / logf(128.f) * 16.f);
    return large < 31 ? large : 31;
}
__device__ __forceinline__ void p0_prologue(CArgs* A, const Ctx& C) {
    LAS float* scr = (LAS float*)(C.lds + C.wave * 16384);
    bf16_t* Win = wsp<bf16_t>(C, WS_WIN);
    constexpr int I1 = 16 * 200, I2 = 16 * 32, I3 = 16 * 32, I4 = 16, I5 = 4 * 32, I6 = 16 * 32, I7 = 16 * 32, I8 = 16 * 16, I9 = 16 * 32, I10 = 8 * 32, I11 = 16 * 176, I12 = 44 * 32;
    constexpr int NITEMS = I1 + I2 + I3 + I4 + I5 + I6 + I7 + I8 + I9 + I10 + I11 + I12;
    for (int it = C.gw; it < NITEMS; it += C.NGW) {
        int r = it;
        if (r < I1) { tr_item(MK_IN(13), 8464, 64 * (r / 200), 32 * (r % 200), 32, Win, D, 32 * (r % 200), nullptr, scr, C.lane); continue; } r -= I1;
        if (r < I2) { tr_item(MK_IN(13), 8464, 64 * (r / 32), 6416 + 32 * (r % 32), 32, Win, D, 6400 + 32 * (r % 32), nullptr, scr, C.lane); continue; } r -= I2;
        if (r < I3) { tr_item(MK_IN(13), 8464, 64 * (r / 32), 7440 + 32 * (r % 32), 32, Win, D, 7424 + 32 * (r % 32), nullptr, scr, C.lane); continue; } r -= I3;
        if (r < I4) { tr_item(MK_IN(13), 8464, 64 * r, 6400, 16, Win, D, 8448, nullptr, scr, C.lane); continue; } r -= I4;
        if (r < I5) { tr_item(MK_IN(18), 1024, 64 * (r / 32), 32 * (r % 32), 32, wsp<bf16_t>(C, WS_WA), 256, 32 * (r % 32), nullptr, scr, C.lane); continue; } r -= I5;
        if (r < I6) { tr_item(MK_IN(19), 1024, 64 * (r / 32), 32 * (r % 32), 32, wsp<bf16_t>(C, WS_WB), D, 32 * (r % 32), nullptr, scr, C.lane); continue; } r -= I6;
        if (r < I7) { tr_item(MK_IN(20), 1024, 64 * (r / 32), 32 * (r % 32), 32, wsp<bf16_t>(C, WS_WOUT), D, 32 * (r % 32), nullptr, scr, C.lane); continue; } r -= I7;
        if (r < I8) { tr_item(MK_IN(23), 512, 64 * (r / 16), 32 * (r % 16), 32, wsp<bf16_t>(C, WS_WMQ), D, 32 * (r % 16), MK_IN(21), scr, C.lane); continue; } r -= I8;
        if (r < I9) { tr_item(MK_IN(24), 1024, 64 * (r / 32), 32 * (r % 32), 32, wsp<bf16_t>(C, WS_WMKV), D, 32 * (r % 32), nullptr, scr, C.lane); continue; } r -= I9;
        if (r < I10) { tr_item(MK_IN(25), 1024, 64 * (r / 32), 32 * (r % 32), 32, wsp<bf16_t>(C, WS_WMO), 512, 32 * (r % 32), nullptr, scr, C.lane); continue; } r -= I10;
        if (r < I11) { tr_item(MK_IN(27), NUP, 64 * (r / 176), 32 * (r % 176), 32, wsp<bf16_t>(C, WS_WUP), D, 32 * (r % 176), MK_IN(26), scr, C.lane); continue; } r -= I11;
        tr_item(MK_IN(30), 1024, 64 * (r / 32), 32 * (r % 32), 32, wsp<bf16_t>(C, WS_WDN), FF, 32 * (r % 32), nullptr, scr, C.lane);
    }
    { u32x4* z = (u32x4*)(Win + (size_t)8480 * D); const int n16 = (NIN - 8480) * D * 2 / 16; for (int i = C.gtid; i < n16; i += C.NGT) z[i] = (u32x4){0u, 0u, 0u, 0u}; }
    bf16_t* XN = wsp<bf16_t>(C, WS_XN); bf16_t* MN = wsp<bf16_t>(C, WS_MN);
    for (int m = C.gw; m < MV; m += C.NGW) rms_row_bf16(m < MP ? MK_IN(0) + (size_t)m * D : MK_IN(1) + (size_t)(m - MP) * D, MK_IN(12), XN + (size_t)m * D, C.lane);
    { u32x4* z = (u32x4*)(XN + (size_t)MV * D); const int n16 = (MT - MV) * D * 2 / 16; for (int i = C.gtid; i < n16; i += C.NGT) z[i] = (u32x4){0u, 0u, 0u, 0u}; }
    for (int m = C.gw; m < 2048; m += C.NGW) rms_row_bf16(MK_IN(10) + (size_t)m * D, MK_IN(22), MN + (size_t)m * D, C.lane);
    { float* bt = wsp<float>(C, WS_BIAS); const float* rb = MK_IN(11);
      for (int i = C.gtid; i < 12 * 129; i += C.NGT) { const int gh = i / 129, j = i % 129, g = gh >> 2, dil = (g == 0) ? 1 : (g == 1 ? 4 : 16); bt[gh * 132 + j] = rb[rel_bucket(dil * j) * 12 + gh]; } }
#pragma unroll
    for (int g = 0; g < 3; ++g) {
        const int L = (g == 0) ? 128 : (g == 1 ? 512 : 2048); const int n4 = (L - 4) * 128;
        const f32x4* src = (const f32x4*)MK_IN(2 + g); f32x4* dst = (f32x4*)(C.out + (g == 0 ? O_DIL0S : (g == 1 ? O_DIL1S : O_DIL2S)));
        const int tot = SB * n4;
        for (int i = C.gtid; i < tot; i += C.NGT) { const int b = i / n4, r = i - b * n4; dst[(size_t)b * L * 128 + r] = __builtin_nontemporal_load(src + (size_t)b * L * 128 + 512 + r); }
    }
}

__device__ __forceinline__ void cp8(const bf16_t* src, float* dst) {
    const u32x4 w = *(const u32x4*)src; float f[8]; unpack8(w, f);
    *(f32x4*)dst = (f32x4){f[0], f[1], f[2], f[3]}; *(f32x4*)(dst + 4) = (f32x4){f[4], f[5], f[6], f[7]};
}
__device__ __forceinline__ void p2_state_copies(CArgs* A, const Ctx& C) {
    const bf16_t* PA = wsp<bf16_t>(C, WS_R1);
#pragma unroll
    for (int g = 0; g < 3; ++g) {
        const int W = (g == 0) ? 128 : (g == 1 ? 512 : 2048);
        float* dp = C.out + (g == 0 ? O_DIL0P : (g == 1 ? O_DIL1P : O_DIL2P));
        const int per_b = W * 64, tot = NB * per_b;
        for (int i = C.gtid; i < tot; i += C.NGT) { const int b = i / per_b, rem = i - b * per_b, rr = rem >> 6, c = (rem & 63) * 8;
            const int col = ((c >> 8) ? PA_VA : PA_KA) + g * 256 + (c & 255);
            cp8(PA + (size_t)(b * SEQ + SEQ - W + rr) * NPA + col, dp + (size_t)i * 8); }
        float* ds = C.out + (g == 0 ? O_DIL0S : (g == 1 ? O_DIL1S : O_DIL2S));
        for (int i = C.gtid; i < SB * ST * 64; i += C.NGT) { const int bt = i >> 6, c = (i & 63) * 8, b = bt >> 2, t = bt & 3;
            const int col = ((c >> 8) ? PA_VA : PA_KA) + g * 256 + (c & 255);
            cp8(PA + (size_t)(MP + bt) * NPA + col, ds + ((size_t)(b * W + W - 4 + t) * 512 + c)); }
    }
    for (int i = C.gtid; i < NB * 3 * 384; i += C.NGT) { const int bi = i / 384, c = (i % 384) * 8, b = bi / 3, ii = bi % 3;
        cp8(PA + (size_t)(b * SEQ + SEQ - 3 + ii) * NPA + PA_QB + c, C.out + O_DCONVP + (size_t)bi * 3072 + c); }
    for (int i = C.gtid; i < SB * 3 * 384; i += C.NGT) { const int bi = i / 384, c = (i % 384) * 8, b = bi / 3, ii = bi % 3;
        cp8(PA + (size_t)(MP + b * 4 + 1 + ii) * NPA + PA_QB + c, C.out + O_DCONVS + (size_t)bi * 3072 + c); }
}

typedef _Float16 f16x8 __attribute__((ext_vector_type(8)));
constexpr int PR_K = 0, PR_Q = 17408, PR_M = 34816, PR_G = PR_M + 8 * 8192, PR_B = PR_G + 2048, PR_END = PR_B + 2048;
static_assert(PR_END <= RING_BYTES, "prep LDS");
template <int I> struct SolveRow {
    static __device__ __forceinline__ void run(float (&t)[64], const LAS unsigned char* Mr, int lane) {
        SolveRow<I - 1>::run(t, Mr, lane);
        float a0 = (lane == I) ? 1.f : 0.f, a1 = 0.f;
#pragma unroll
        for (int j8 = 0; j8 < (I + 7) / 8; ++j8) { const f16x8 hv = *(const LAS f16x8*)(Mr + I * 128 + j8 * 16);
#pragma unroll
            for (int e = 0; e < 8; ++e) { const int jj = j8 * 8 + e; if (jj < I) { if (e & 1) a1 -= (float)hv[e] * t[jj]; else a0 -= (float)hv[e] * t[jj]; } } }
        t[I] = a0 + a1;
    }
};
template <> struct SolveRow<-1> { static __device__ __forceinline__ void run(float (&)[64], const LAS unsigned char*, int) {} };
__device__ __forceinline__ void gdn_prep_unit(CArgs* A, const Ctx& C, int unit) {
    const int b = unit >> 5, h = (unit >> 2) & 7, j = unit & 3;
    const bf16_t* PA = wsp<bf16_t>(C, WS_R1); const bf16_t* PB = wsp<bf16_t>(C, WS_R2);
    unsigned char* CH = wsp<unsigned char>(C, WS_R3);
    const int tid = C.tid, lane = C.lane, wave = C.wave, lr = lane & 15, q = lane >> 4;
    const int cg = tid % 48, tensor = cg >> 4, chg = cg & 15, rg = tid / 48;
    const int cidx = tensor * 1024 + h * 128 + 8 * chg;
    float w[4][8];
    if (tid < 384) {
#pragma unroll
        for (int jj = 0; jj < 4; ++jj) { const f32x4 a = *(const f32x4*)(MK_IN(14) + jj * 3072 + cidx), bq = *(const f32x4*)(MK_IN(14) + jj * 3072 + cidx + 4);
            w[jj][0] = a[0]; w[jj][1] = a[1]; w[jj][2] = a[2]; w[jj][3] = a[3]; w[jj][4] = bq[0]; w[jj][5] = bq[1]; w[jj][6] = bq[2]; w[jj][7] = bq[3]; }
    }
    __syncthreads();
    for (int ci = 0; ci < 8; ++ci) {
        const int n = 8 * j + ci, chunk = (b * 8 + h) * 32 + n, t0 = 64 * n;
        unsigned char* rec = CH + (size_t)chunk * CH_STRIDE;
        if (tid < 384) {
            float x[11][8];
#pragma unroll
            for (int i = 0; i < 11; ++i) { const int t = t0 + 8 * rg - 3 + i;
                if (t >= 0) { const u32x4 wv = *(const u32x4*)(PA + (size_t)(b * SEQ + t) * NPA + PA_QB + cidx); unpack8(wv, x[i]); }
                else {
#pragma unroll
                    for (int e = 0; e < 8; ++e) x[i][e] = 0.f; } }
#pragma unroll
            for (int r = 0; r < 8; ++r) { float y[8]; float ss = 0.f;
#pragma unroll
                for (int e = 0; e < 8; ++e) { float a = w[0][e] * x[r][e]; a += w[1][e] * x[r + 1][e]; a += w[2][e] * x[r + 2][e]; a += w[3][e] * x[r + 3][e]; a = siluf_(a); y[e] = a; ss += a * a; }
                ss += __shfl_xor(ss, 1); ss += __shfl_xor(ss, 2); ss += __shfl_xor(ss, 4); ss += __shfl_xor(ss, 8);
                const float sc = (tensor == 0) ? rsqrtf(ss + EPS) * 0.08838834764831845f : (tensor == 1 ? rsqrtf(ss + EPS) : 1.f);
                u32x4 o; o.x = cvt_pk_bf16(y[0] * sc, y[1] * sc); o.y = cvt_pk_bf16(y[2] * sc, y[3] * sc); o.z = cvt_pk_bf16(y[4] * sc, y[5] * sc); o.w = cvt_pk_bf16(y[6] * sc, y[7] * sc);
                const int row = 8 * rg + r;
                *(u32x4*)(rec + (tensor == 0 ? 16384 : (tensor == 1 ? 0 : 32768)) + row * 256 + chg * 16) = o;
                if (tensor < 2) *(LAS u32x4*)(C.lds + (tensor == 0 ? PR_Q : PR_K) + row * 272 + chg * 16) = o; }
        } else if (wave == 6) {
            const size_t row = (size_t)(b * SEQ + t0 + lane);
            const float braw = bf2f(PB[row * NPB + PB_BETA + h]), araw = bf2f(PB[row * NPB + PB_A + h]);
            const float beta = sigmoidf_(braw); const float xx = araw + MK_IN(16)[h];
            const float sp = fmaxf(xx, 0.f) + log1pf(__expf(-fabsf(xx)));
            float Gc = -__expf(MK_IN(15)[h]) * sp;
#pragma unroll
            for (int o = 1; o < 64; o <<= 1) { const float up = __shfl_up(Gc, o); if (lane >= o) Gc += up; }
            const float Gl = __shfl(Gc, 63);
            ((LAS float*)(C.lds + PR_G))[ci * 64 + lane] = Gc; ((LAS float*)(C.lds + PR_B))[ci * 64 + lane] = beta;
            float* gv = (float*)(rec + 65536); gv[lane] = __expf(Gc); gv[64 + lane] = __expf(Gl - Gc); if (lane == 0) gv[128] = __expf(Gl);
        }
        __syncthreads();
        {
            const int mi = wave >> 1, nh = wave & 1;
            const LAS float* Gs = (const LAS float*)(C.lds + PR_G) + ci * 64; const LAS float* Bs = (const LAS float*)(C.lds + PR_B) + ci * 64;
#pragma unroll
            for (int t2 = 0; t2 < 2; ++t2) { const int ni = 2 * nh + t2;
                f32x4 kk = {0.f, 0.f, 0.f, 0.f}, qk = {0.f, 0.f, 0.f, 0.f};
                if (ni <= mi) {
#pragma unroll
                    for (int s = 0; s < 4; ++s) {
                        const bf16x8 ak = *(const LAS bf16x8*)(C.lds + PR_K + (16 * mi + lr) * 272 + (32 * s + 8 * q) * 2);
                        const bf16x8 aq = *(const LAS bf16x8*)(C.lds + PR_Q + (16 * mi + lr) * 272 + (32 * s + 8 * q) * 2);
                        const bf16x8 bk = *(const LAS bf16x8*)(C.lds + PR_K + (16 * ni + lr) * 272 + (32 * s + 8 * q) * 2);
                        kk = __builtin_amdgcn_mfma_f32_16x16x32_bf16(ak, bk, kk, 0, 0, 0);
                        qk = __builtin_amdgcn_mfma_f32_16x16x32_bf16(aq, bk, qk, 0, 0, 0); }
                }
                const int e = 16 * ni + lr; const float Ge = Gs[e];
#pragma unroll
                for (int r = 0; r < 4; ++r) { const int c = 16 * mi + 4 * q + r; const float gam = (c >= e) ? __expf(Gs[c] - Ge) : 0.f;
                    const float mval = (c > e) ? Bs[c] * kk[r] * gam : 0.f; const float aval = qk[r] * gam;
                    *(LAS _Float16*)(C.lds + PR_M + ci * 8192 + (c * 64 + e) * 2) = (_Float16)mval;
                    *(bf16_t*)(rec + 57344 + (c * 64 + e) * 2) = f2bf(aval); }
            }
        }
        __syncthreads();
    }
    {
        const int ci = wave, chunk = (b * 8 + h) * 32 + 8 * j + ci;
        unsigned char* rec = CH + (size_t)chunk * CH_STRIDE;
        const LAS unsigned char* Mr = C.lds + PR_M + ci * 8192;
        float t[64];
        SolveRow<63>::run(t, Mr, lane);
        const float bc = ((const LAS float*)(C.lds + PR_B))[ci * 64 + lane];
        bf16_t* tp = (bf16_t*)(rec + 49152);
#pragma unroll
        for (int i = 0; i < 64; ++i) tp[i * 64 + lane] = f2bf(t[i] * bc);
    }
}

constexpr int SC_KN = 0, SC_QN = 17408, SC_V = 34816, SC_KT = 52224, SC_TP = 70656, SC_AI = 79872, SC_EG = 89088, SC_END = SC_EG + 1024;
static_assert(SC_END <= RING_BYTES, "scan LDS");
__device__ __forceinline__ bf16x8 packB(const f32x4 a, const f32x4 b) { const u32x4 w = pack8(a, b); return __builtin_bit_cast(bf16x8, w); }
__device__ __forceinline__ bf16x8 ld_perm(const LAS unsigned char* base, int row, int stride, int k0, int q) {
    const u32x2 lo = *(const LAS u32x2*)(base + row * stride + (k0 + 4 * q) * 2), hi = *(const LAS u32x2*)(base + row * stride + (k0 + 16 + 4 * q) * 2);
    const u32x4 w = {lo.x, lo.y, hi.x, hi.y}; return __builtin_bit_cast(bf16x8, w);
}
__device__ __forceinline__ void gdn_scan_unit(CArgs* A, const Ctx& C, int bh) {
    const int tid = C.tid, lane = C.lane, wave = C.wave, lr = lane & 15, q = lane >> 4;
    const int b = bh >> 3, h = bh & 7;
    const unsigned char* CH = wsp<unsigned char>(C, WS_R3) + (size_t)bh * 32 * CH_STRIDE;
    bf16_t* PA = wsp<bf16_t>(C, WS_R1);
    f32x4 S[8];
#pragma unroll
    for (int i = 0; i < 8; ++i) S[i] = (f32x4){0.f, 0.f, 0.f, 0.f};
    u32x4 pf[8]; float pfg = 0.f;
#define SC_PREFETCH(n_) do { const unsigned char* base_ = CH + (size_t)(n_) * CH_STRIDE; _Pragma("unroll") for (int i_ = 0; i_ < 8; ++i_) pf[i_] = *(const u32x4*)(base_ + (size_t)(tid + 512 * i_) * 16); \
        if (tid < 129) pfg = *(const float*)(base_ + 65536 + tid * 4); } while (0)
    SC_PREFETCH(0);
    for (int n = 0; n < 32; ++n) {
        __syncthreads();
#pragma unroll
        for (int i = 0; i < 6; ++i) { const int p = tid + 512 * (i & 1), row = p >> 4, cp = p & 15; const int off = (i < 2) ? SC_KN : (i < 4 ? SC_QN : SC_V);
            *(LAS u32x4*)(C.lds + off + row * 272 + cp * 16) = pf[i];
            if (i < 2) {
#pragma unroll
                for (int e = 0; e < 8; ++e) { const unsigned wv = pf[i][e >> 1]; *(LAS bf16_t*)(C.lds + SC_KT + (8 * cp + e) * 144 + row * 2) = (bf16_t)((e & 1) ? (wv >> 16) : (wv & 0xffffu)); } } }
        { const int row = tid >> 3, cp = tid & 7; *(LAS u32x4*)(C.lds + SC_TP + row * 144 + cp * 16) = pf[6]; *(LAS u32x4*)(C.lds + SC_AI + row * 144 + cp * 16) = pf[7]; }
        if (tid < 129) ((LAS float*)(C.lds + SC_EG))[tid] = pfg;
        __syncthreads();
        if (n + 1 < 32) SC_PREFETCH(n + 1);
        const LAS float* EG = (const LAS float*)(C.lds + SC_EG);
        f32x4 ks[4], qs[4];
#pragma unroll
        for (int mt = 0; mt < 4; ++mt) { ks[mt] = (f32x4){0.f, 0.f, 0.f, 0.f}; qs[mt] = (f32x4){0.f, 0.f, 0.f, 0.f}; }
#pragma unroll
        for (int s = 0; s < 4; ++s) { const bf16x8 bS = packB(S[2 * s], S[2 * s + 1]);
#pragma unroll
            for (int mt = 0; mt < 4; ++mt) {
                ks[mt] = __builtin_amdgcn_mfma_f32_16x16x32_bf16(ld_perm(C.lds + SC_KN, 16 * mt + lr, 272, 32 * s, q), bS, ks[mt], 0, 0, 0);
                qs[mt] = __builtin_amdgcn_mfma_f32_16x16x32_bf16(ld_perm(C.lds + SC_QN, 16 * mt + lr, 272, 32 * s, q), bS, qs[mt], 0, 0, 0); } }
        f32x4 R[4], eg[4];
#pragma unroll
        for (int mt = 0; mt < 4; ++mt) { eg[mt] = *(const LAS f32x4*)(EG + 16 * mt + 4 * q);
#pragma unroll
            for (int r = 0; r < 4; ++r) { const float vv = bf2f(*(const LAS bf16_t*)(C.lds + SC_V + (16 * mt + 4 * q + r) * 272 + (16 * wave + lr) * 2)); R[mt][r] = vv - eg[mt][r] * ks[mt][r]; } }
        f32x4 vn[4];
#pragma unroll
        for (int mt = 0; mt < 4; ++mt) vn[mt] = (f32x4){0.f, 0.f, 0.f, 0.f};
#pragma unroll
        for (int s = 0; s < 2; ++s) { const bf16x8 bR = packB(R[2 * s], R[2 * s + 1]);
#pragma unroll
            for (int mt = 2 * s; mt < 4; ++mt) vn[mt] = __builtin_amdgcn_mfma_f32_16x16x32_bf16(ld_perm(C.lds + SC_TP, 16 * mt + lr, 144, 32 * s, q), bR, vn[mt], 0, 0, 0); }
#pragma unroll
        for (int mt = 0; mt < 4; ++mt) qs[mt] = qs[mt] * eg[mt];
#if defined(MK_SCANDBG) && MK_SCANDBG == 1
        f32x4 qsave[4];
        for (int mt = 0; mt < 4; ++mt) qsave[mt] = qs[mt];
#elif defined(MK_SCANDBG) && MK_SCANDBG == 2
        for (int mt = 0; mt < 4; ++mt) qs[mt] = (f32x4){0.f, 0.f, 0.f, 0.f};
#elif defined(MK_SCANDBG) && MK_SCANDBG == 3
        f32x4 qsave[4];
        for (int mt = 0; mt < 4; ++mt) qsave[mt] = R[mt];
#elif defined(MK_SCANDBG) && MK_SCANDBG == 4
        f32x4 qsave[4];
        for (int mt = 0; mt < 4; ++mt) qsave[mt] = vn[mt];
#elif defined(MK_SCANDBG) && MK_SCANDBG == 5
        f32x4 qsave[4];
        for (int mt = 0; mt < 4; ++mt) qsave[mt] = ks[mt];
#endif
#pragma unroll
        for (int s = 0; s < 2; ++s) { const bf16x8 bV = packB(vn[2 * s], vn[2 * s + 1]);
#pragma unroll
            for (int mt = 2 * s; mt < 4; ++mt) qs[mt] = __builtin_amdgcn_mfma_f32_16x16x32_bf16(ld_perm(C.lds + SC_AI, 16 * mt + lr, 144, 32 * s, q), bV, qs[mt], 0, 0, 0); }
#pragma unroll
        for (int mt = 0; mt < 4; ++mt)
#pragma unroll
#if defined(MK_SCANDBG) && (MK_SCANDBG == 1 || MK_SCANDBG >= 3)
            for (int r = 0; r < 4; ++r) PA[(size_t)(b * SEQ + 64 * n + 16 * mt + 4 * q + r) * NPA + PA_QB + h * 128 + 16 * wave + lr] = f2bf(qsave[mt][r]);
#else
            for (int r = 0; r < 4; ++r) PA[(size_t)(b * SEQ + 64 * n + 16 * mt + 4 * q + r) * NPA + PA_QB + h * 128 + 16 * wave + lr] = f2bf(qs[mt][r]);
#endif
        const float dec = EG[128];
#pragma unroll
        for (int mt = 0; mt < 4; ++mt) { const f32x4 egl = *(const LAS f32x4*)(EG + 64 + 16 * mt + 4 * q); vn[mt] = vn[mt] * egl; }
#pragma unroll
        for (int tk = 0; tk < 8; ++tk) S[tk] = S[tk] * dec;
#pragma unroll
        for (int s = 0; s < 2; ++s) { const bf16x8 bW = packB(vn[2 * s], vn[2 * s + 1]);
#pragma unroll
            for (int tk = 0; tk < 8; ++tk) S[tk] = __builtin_amdgcn_mfma_f32_16x16x32_bf16(ld_perm(C.lds + SC_KT, 16 * tk + lr, 144, 32 * s, q), bW, S[tk], 0, 0, 0); }
    }
#undef SC_PREFETCH
    float* so = C.out + O_DSTP + (size_t)bh * 128 * 128;
#pragma unroll
    for (int tk = 0; tk < 8; ++tk)
#pragma unroll
        for (int r = 0; r < 4; ++r) so[(16 * tk + 4 * q + r) * 128 + 16 * wave + lr] = S[tk][r];
}

template <int DH, int NT, bool BAND>
__device__ __forceinline__ void attn_wave(const LAS unsigned char* Kl, int KS, const LAS unsigned char* Vl, int VS, int tile0, const bf16_t* qrow,
                                          const LAS float* bias, int kmin, float scale, int lr, int q, f32x4 (&o)[DH / 16], float& mx_out, float& sum_out) {
    bf16x8 qf[DH / 32];
#pragma unroll
    for (int s = 0; s < DH / 32; ++s) qf[s] = *(const bf16x8*)(qrow + 32 * s + 8 * q);
    f32x4 sc[NT];
#pragma unroll
    for (int j = 0; j < NT; ++j) { sc[j] = (f32x4){0.f, 0.f, 0.f, 0.f};
#pragma unroll
        for (int s = 0; s < DH / 32; ++s) { const bf16x8 kf = *(const LAS bf16x8*)(Kl + (16 * (tile0 + j) + lr) * KS + (32 * s + 8 * q) * 2);
            sc[j] = __builtin_amdgcn_mfma_f32_16x16x32_bf16(kf, qf[s], sc[j], 0, 0, 0); }
        if (DH > 64) asm volatile("" ::: "memory"); }
    float mx = -INFINITY;
#pragma unroll
    for (int j = 0; j < NT; ++j)
#pragma unroll
        for (int r = 0; r < 4; ++r) { float sv = sc[j][r] * scale;
            if (BAND) { const int dist = 128 + lr - 16 * j - 4 * q - r; const int kidx = 16 * (tile0 + j) + 4 * q + r;
                const bool ok = (dist >= 0) && (dist <= 128) && (kidx >= kmin); const int dc = dist < 0 ? 0 : (dist > 128 ? 128 : dist);
                sv = ok ? sv + bias[dc] : -INFINITY; }
            sc[j][r] = sv; mx = fmaxf(mx, sv); }
    mx = fmaxf(mx, __shfl_xor(mx, 16)); mx = fmaxf(mx, __shfl_xor(mx, 32));
    float sum = 0.f;
#pragma unroll
    for (int j = 0; j < NT; ++j)
#pragma unroll
        for (int r = 0; r < 4; ++r) { const float p = __expf(sc[j][r] - mx); sc[j][r] = p; sum += p; }
    sum += __shfl_xor(sum, 16); sum += __shfl_xor(sum, 32);
#pragma unroll
    for (int mt = 0; mt < DH / 16; ++mt) o[mt] = (f32x4){0.f, 0.f, 0.f, 0.f};
#pragma unroll
    for (int i = 0; i < (NT + 1) / 2; ++i) {
        const bool two = (2 * i + 1 < NT);
        const f32x4 z4 = {0.f, 0.f, 0.f, 0.f};
        const bf16x8 pb = packB(sc[2 * i], two ? sc[(2 * i + 1 < NT) ? 2 * i + 1 : 2 * i] : z4);
#pragma unroll
        for (int mt = 0; mt < DH / 16; ++mt) {
            const u32x2 lo = *(const LAS u32x2*)(Vl + (16 * mt + lr) * VS + (16 * (tile0 + 2 * i) + 4 * q) * 2);
            u32x2 hi = {0u, 0u}; if (two) hi = *(const LAS u32x2*)(Vl + (16 * mt + lr) * VS + (16 * (tile0 + 2 * i + 1) + 4 * q) * 2);
            const u32x4 aw = {lo.x, lo.y, hi.x, hi.y};
            o[mt] = __builtin_amdgcn_mfma_f32_16x16x32_bf16(__builtin_bit_cast(bf16x8, aw), pb, o[mt], 0, 0, 0); }
        if (DH > 64) asm volatile("" ::: "memory"); }
    mx_out = mx; sum_out = sum;
}
constexpr int AT_K = 0;
constexpr int ATD_KS = 144, ATD_VS = 528, ATD_VT = 256 * ATD_KS, ATD_BIAS = ATD_VT + 64 * ATD_VS;
constexpr int ATC_KS = 272, ATC_VS = 528, ATC_VT = 256 * ATC_KS, ATC_END = ATC_VT + 128 * ATC_VS;
static_assert(ATC_END <= RING_BYTES && ATD_BIAS + 1024 <= RING_BYTES, "attention LDS");
template <int DH>
__device__ __forceinline__ void stage_kv(LAS unsigned char* Kl, int KS, LAS unsigned char* Vl, int VS, const bf16_t* kp, int voff, int key, int half) {
    constexpr int NP = DH / 16;
    u32x4 kv[NP], vv[NP];
#pragma unroll
    for (int i = 0; i < NP; ++i) { if (kp) { kv[i] = *(const u32x4*)(kp + half * (DH / 2) + 8 * i); vv[i] = *(const u32x4*)(kp + voff + half * (DH / 2) + 8 * i); } else { kv[i] = (u32x4){0u, 0u, 0u, 0u}; vv[i] = kv[i]; } }
#pragma unroll
    for (int i = 0; i < NP; ++i) { *(LAS u32x4*)(Kl + key * KS + (half * (DH / 2) + 8 * i) * 2) = kv[i];
#pragma unroll
        for (int e = 0; e < 8; ++e) { const unsigned wv = vv[i][e >> 1]; *(LAS bf16_t*)(Vl + (half * (DH / 2) + 8 * i + e) * VS + key * 2) = (bf16_t)((e & 1) ? (wv >> 16) : (wv & 0xffffu)); } }
}
__device__ __forceinline__ void dil_attn_unit(CArgs* A, const Ctx& C, int u) {
    const int b = u / 192, rem = u % 192, gh = rem >> 4, sub = rem & 15, g = gh >> 2, h = gh & 3;
    const int dil = (g == 0) ? 1 : (g == 1 ? 4 : 16), nblk = 16 / dil, res = sub / nblk, qb = sub % nblk, i0 = 128 * qb;
    bf16_t* PA = wsp<bf16_t>(C, WS_R1); float* LSE = wsp<float>(C, WS_LSE);
    const int tid = C.tid, lane = C.lane, wave = C.wave, lr = lane & 15, q = lane >> 4;
    __syncthreads();
    { const int key = tid >> 1, half = tid & 1, kidx = i0 - 128 + key;
      const bf16_t* kp = (kidx >= 0) ? PA + (size_t)(b * SEQ + res + dil * kidx) * NPA + PA_KA + gh * 64 : nullptr;
      stage_kv<64>(C.lds + AT_K, ATD_KS, C.lds + ATD_VT, ATD_VS, kp, PA_VA - PA_KA, key, half);
      if (tid < 129) ((LAS float*)(C.lds + ATD_BIAS))[tid] = wsp<float>(C, WS_BIAS)[gh * 132 + tid]; }
    __syncthreads();
    const int tok = b * SEQ + res + dil * (i0 + 16 * wave + lr);
    bf16_t* qrow = PA + (size_t)tok * NPA + PA_QA + gh * 64;
    f32x4 o[4]; float mx, sum;
    attn_wave<64, 9, true>(C.lds + AT_K, ATD_KS, C.lds + ATD_VT, ATD_VS, wave, qrow, (const LAS float*)(C.lds + ATD_BIAS), 128 - i0, 0.125f, lr, q, o, mx, sum);
    const float inv = 1.f / sum;
#pragma unroll
    for (int mt = 0; mt < 4; ++mt) { u32x2 w; w.x = cvt_pk_bf16(o[mt][0] * inv, o[mt][1] * inv); w.y = cvt_pk_bf16(o[mt][2] * inv, o[mt][3] * inv); *(u32x2*)(qrow + 16 * mt + 4 * q) = w; }
    if (q == 0) LSE[((size_t)g * MP + tok) * 4 + h] = mx + __logf(sum);
}
__device__ __forceinline__ void cross_attn_unit(CArgs* A, const Ctx& C, int u) {
    const int b = u >> 5, h = (u >> 3) & 3, sp = u & 7;
    const bf16_t* MKV = wsp<bf16_t>(C, WS_MEMKV); const bf16_t* QM = wsp<bf16_t>(C, WS_QM); bf16_t* OM = wsp<bf16_t>(C, WS_OM);
    const int tid = C.tid, lane = C.lane, wave = C.wave, lr = lane & 15, q = lane >> 4;
    __syncthreads();
    { const int key = tid >> 1, half = tid & 1; stage_kv<128>(C.lds + AT_K, ATC_KS, C.lds + ATC_VT, ATC_VS, MKV + (size_t)(b * 256 + key) * 1024 + h * 128, 512, key, half); }
    __syncthreads();
#pragma unroll 1
    for (int blk = 0; blk < 2; ++blk) {
        const int tok = b * SEQ + sp * 256 + blk * 128 + 16 * wave + lr;
        f32x4 o[8]; float mx, sum;
        attn_wave<128, 16, false>(C.lds + AT_K, ATC_KS, C.lds + ATC_VT, ATC_VS, 0, QM + (size_t)tok * 512 + h * 128, nullptr, 0, 0.08838834764831845f, lr, q, o, mx, sum);
        const float inv = 1.f / sum;
#pragma unroll
        for (int mt = 0; mt < 8; ++mt) { u32x2 w; w.x = cvt_pk_bf16(o[mt][0] * inv, o[mt][1] * inv); w.y = cvt_pk_bf16(o[mt][2] * inv, o[mt][3] * inv); *(u32x2*)(OM + (size_t)tok * 512 + h * 128 + 16 * mt + 4 * q) = w; }
    }
}

__device__ __forceinline__ void dil_sample_unit(CArgs* A, const Ctx& C, int u) {
    const int b = u >> 2, h = u & 3;
    const int tid = C.tid, lane = C.lane, wave = C.wave;
    const bf16_t* PA = wsp<bf16_t>(C, WS_R1); bf16_t* OA = wsp<bf16_t>(C, WS_OA); const float* BT = wsp<float>(C, WS_BIAS);
    LAS float* qs = (LAS float*)C.lds + wave * 64;
    LAS float* scb = (LAS float*)C.lds + 512 + wave * 192;
    LAS float* res = (LAS float*)C.lds + 2048;
    LAS float* lseb = (LAS float*)C.lds + 2048 + 768;
    __syncthreads();
    for (int task = wave; task < 12; task += 8) {
        const int g = task >> 2, t = task & 3, gh = g * 4 + h;
        const int dil = (g == 0) ? 1 : (g == 1 ? 4 : 16), L = 128 * dil;
        const float* cache = MK_IN(2 + g); const float* outc = C.out + (g == 0 ? O_DIL0S : (g == 1 ? O_DIL1S : O_DIL2S));
        qs[lane] = bf2f(PA[(size_t)(MP + b * 4 + t) * NPA + PA_QA + gh * 64 + lane]);
        LDS_WAIT();
        float sv[3]; float mx = -INFINITY;
#pragma unroll
        for (int pass = 0; pass < 3; ++pass) { const int jn = pass * 64 + lane; sv[pass] = -INFINITY;
            if (jn <= 128) { const int ci = L + t - dil * jn;
                const float* kr = (ci < L) ? cache + ((size_t)(b * L + ci) * 512 + h * 64) : outc + ((size_t)(b * L + L - 4 + (ci - L)) * 512 + h * 64);
                float acc = 0.f;
#pragma unroll
                for (int d4 = 0; d4 < 16; ++d4) { const f32x4 kv = *(const f32x4*)(kr + 4 * d4); const f32x4 qv = *(const LAS f32x4*)(qs + 4 * d4); acc += (kv[0] * qv[0] + kv[1] * qv[1]) + (kv[2] * qv[2] + kv[3] * qv[3]); }
                sv[pass] = acc * 0.125f + BT[gh * 132 + jn]; }
            mx = fmaxf(mx, sv[pass]); }
        mx = wave_max(mx);
        float sum = 0.f;
#pragma unroll
        for (int pass = 0; pass < 3; ++pass) { const int jn = pass * 64 + lane; const float p = (jn <= 128) ? __expf(sv[pass] - mx) : 0.f; sum += p; if (jn <= 128) scb[jn] = p; }
        sum = wave_sum(sum);
        LDS_WAIT();
        float acc = 0.f;
        for (int jn = 0; jn <= 128; ++jn) { const int ci = L + t - dil * jn;
            const float* vr = (ci < L) ? cache + ((size_t)(b * L + ci) * 512 + 256 + h * 64) : outc + ((size_t)(b * L + L - 4 + (ci - L)) * 512 + 256 + h * 64);
            acc += scb[jn] * vr[lane]; }
        res[task * 64 + lane] = acc / sum;
        if (lane == 0) lseb[task] = mx + __logf(sum);
    }
    __syncthreads();
    if (tid < 256) { const int t = tid >> 6, d = tid & 63;
        const float l0 = lseb[t], l1 = lseb[4 + t], l2 = lseb[8 + t]; const float m = fmaxf(l0, fmaxf(l1, l2));
        const float w0 = __expf(l0 - m), w1 = __expf(l1 - m), w2 = __expf(l2 - m);
        const float v = (w0 * res[t * 64 + d] + w1 * res[(4 + t) * 64 + d] + w2 * res[(8 + t) * 64 + d]) / (w0 + w1 + w2);
        OA[(size_t)(MP + b * 4 + t) * 256 + h * 64 + d] = f2bf(v); }
}
__device__ __forceinline__ void cross_sample_unit(CArgs* A, const Ctx& C, int u) {
    const int b = u >> 2, h = u & 3;
    const int tid = C.tid, lane = C.lane, wave = C.wave;
    const bf16_t* QM = wsp<bf16_t>(C, WS_QM); bf16_t* OM = wsp<bf16_t>(C, WS_OM);
    const float* ck = MK_IN(7); const float* cv = MK_IN(8);
    LAS float* qs = (LAS float*)C.lds + wave * 128;
    LAS float* scb = (LAS float*)C.lds + 1024 + wave * 128;
    LAS float* res = (LAS float*)C.lds + 2048;
    LAS float* ml = (LAS float*)C.lds + 3072;
    __syncthreads();
    const int t = wave & 3, half = wave >> 2;
    const bf16_t* qp = QM + (size_t)(MP + b * 4 + t) * 512 + h * 128;
    qs[lane] = bf2f(qp[lane]); qs[64 + lane] = bf2f(qp[64 + lane]);
    LDS_WAIT();
    float sv[2]; float mx = -INFINITY;
#pragma unroll
    for (int pass = 0; pass < 2; ++pass) { const int m = half * 128 + pass * 64 + lane; const float* kr = ck + ((size_t)(b * 256 + m) * 4 + h) * 128; float acc = 0.f;
#pragma unroll 8
        for (int d4 = 0; d4 < 32; ++d4) { const f32x4 kv = *(const f32x4*)(kr + 4 * d4); const f32x4 qv = *(const LAS f32x4*)(qs + 4 * d4); acc += (kv[0] * qv[0] + kv[1] * qv[1]) + (kv[2] * qv[2] + kv[3] * qv[3]); }
        sv[pass] = acc * 0.08838834764831845f; mx = fmaxf(mx, sv[pass]); }
    mx = wave_max(mx);
    float sum = 0.f;
#pragma unroll
    for (int pass = 0; pass < 2; ++pass) { const float p = __expf(sv[pass] - mx); sum += p; scb[pass * 64 + lane] = p; }
    sum = wave_sum(sum);
    LDS_WAIT();
    float a0 = 0.f, a1 = 0.f;
    for (int jn = 0; jn < 128; ++jn) { const float* vr = cv + ((size_t)(b * 256 + half * 128 + jn) * 4 + h) * 128; const float p = scb[jn]; a0 += p * vr[lane]; a1 += p * vr[64 + lane]; }
    res[wave * 128 + lane] = a0; res[wave * 128 + 64 + lane] = a1;
    if (lane == 0) { ml[wave * 2] = mx; ml[wave * 2 + 1] = sum; }
    __syncthreads();
    { const int tt = tid >> 7, d = tid & 127; const float m0 = ml[tt * 2], l0 = ml[tt * 2 + 1], m1 = ml[(tt + 4) * 2], l1 = ml[(tt + 4) * 2 + 1];
      const float m = fmaxf(m0, m1), e0 = __expf(m0 - m), e1 = __expf(m1 - m);
      OM[(size_t)(MP + b * 4 + tt) * 512 + h * 128 + d] = f2bf((res[tt * 128 + d] * e0 + res[(tt + 4) * 128 + d] * e1) / (l0 * e0 + l1 * e1)); }
}
__device__ __forceinline__ void gdn_sample_unit(CArgs* A, const Ctx& C, int u) {
    const int b = u >> 3, h = u & 7;
    const int tid = C.tid, lane = C.lane, wave = C.wave;
    const bf16_t* PA = wsp<bf16_t>(C, WS_R1); const bf16_t* PB = wsp<bf16_t>(C, WS_R2); bf16_t* OB = wsp<bf16_t>(C, WS_XN);
    LAS float* xs = (LAS float*)C.lds;
    LAS float* red = (LAS float*)C.lds + 1536;
    LAS float* osb = (LAS float*)C.lds + 2048;
    LAS float* sc8 = (LAS float*)C.lds + 2560;
    __syncthreads();
    if (tid < 384) { const int tensor = tid >> 7, ch = tid & 127, cidx = tensor * 1024 + h * 128 + ch;
        float xp[7];
#pragma unroll
        for (int i = 0; i < 3; ++i) xp[i] = MK_IN(6)[(size_t)(b * 3 + i) * 3072 + cidx];
#pragma unroll
        for (int t = 0; t < 4; ++t) xp[3 + t] = bf2f(PA[(size_t)(MP + b * 4 + t) * NPA + PA_QB + cidx]);
        float wv[4];
#pragma unroll
        for (int jj = 0; jj < 4; ++jj) wv[jj] = MK_IN(14)[jj * 3072 + cidx];
#pragma unroll
        for (int t = 0; t < 4; ++t) { float a = wv[0] * xp[t] + wv[1] * xp[t + 1] + wv[2] * xp[t + 2] + wv[3] * xp[t + 3]; xs[t * 384 + tid] = siluf_(a); } }
    __syncthreads();
    { const int tensor = wave >> 2, t = wave & 3; const float a = xs[t * 384 + tensor * 128 + lane], c = xs[t * 384 + tensor * 128 + 64 + lane];
      const float ss = wave_sum(a * a + c * c); if (lane == 0) sc8[wave] = rsqrtf(ss + EPS) * (tensor == 0 ? 0.08838834764831845f : 1.f); }
    __syncthreads();
    if (tid < 256) { const int tensor = tid >> 7;
#pragma unroll
        for (int t = 0; t < 4; ++t) xs[t * 384 + tid] *= sc8[tensor * 4 + t]; }
    const int v = tid & 127, kg = tid >> 7;
    float S[32];
    const float* s0 = MK_IN(5) + ((size_t)(b * 8 + h) * 128 + kg * 32) * 128 + v;
#pragma unroll
    for (int i = 0; i < 32; ++i) S[i] = s0[(size_t)i * 128];
    __syncthreads();
#pragma unroll 1
    for (int t = 0; t < 4; ++t) {
        const size_t row = (size_t)(MP + b * 4 + t);
        const float beta = sigmoidf_(bf2f(PB[row * NPB + PB_BETA + h])); const float xx = bf2f(PB[row * NPB + PB_A + h]) + MK_IN(16)[h];
        const float a = __expf(-__expf(MK_IN(15)[h]) * (fmaxf(xx, 0.f) + log1pf(__expf(-fabsf(xx)))));
        const LAS float* kq = xs + t * 384;
        float part = 0.f;
#pragma unroll
        for (int i = 0; i < 32; ++i) part += kq[128 + kg * 32 + i] * S[i];
        red[kg * 128 + v] = part;
        __syncthreads();
        const float kS = red[v] + red[128 + v] + red[256 + v] + red[384 + v];
        const float uu = beta * (kq[256 + v] - a * kS);
        float po = 0.f;
#pragma unroll
        for (int i = 0; i < 32; ++i) { S[i] = a * S[i] + kq[128 + kg * 32 + i] * uu; po += kq[kg * 32 + i] * S[i]; }
        __syncthreads();
        red[kg * 128 + v] = po;
        __syncthreads();
        if (kg == 0) osb[t * 128 + v] = red[v] + red[128 + v] + red[256 + v] + red[384 + v];
        __syncthreads();
    }
    float* so = C.out + O_DSTS + ((size_t)(b * 8 + h) * 128 + kg * 32) * 128 + v;
#pragma unroll
    for (int i = 0; i < 32; ++i) so[(size_t)i * 128] = S[i];
    { const int t = tid >> 7; const float ov = osb[t * 128 + v]; float ss = wave_sum(ov * ov);
      if (lane == 0) red[wave] = ss;
      __syncthreads();
      const float tot = red[2 * t] + red[2 * t + 1]; const float rs = rsqrtf(tot * (1.f / 128.f) + EPS);
      const size_t row = (size_t)(MP + b * 4 + t);
      const float z = bf2f(PB[row * NPB + PB_Z + h * 128 + v]);
      OB[row * D + h * 128 + v] = f2bf(ov * rs * MK_IN(17)[v] * siluf_(z)); }
}

__device__ __forceinline__ void p4_merge(CArgs* A, const Ctx& C) {
    const bf16_t* PA = wsp<bf16_t>(C, WS_R1); const bf16_t* PB = wsp<bf16_t>(C, WS_R2); const float* LSE = wsp<float>(C, WS_LSE);
    bf16_t* OA = wsp<bf16_t>(C, WS_OA); bf16_t* OB = wsp<bf16_t>(C, WS_XN);
    const int lane = C.lane;
    for (int tok = C.gw; tok < MP; tok += C.NGW) {
        { const int col = 4 * lane, hh = col >> 6;
          const float l0 = LSE[((size_t)0 * MP + tok) * 4 + hh], l1 = LSE[((size_t)1 * MP + tok) * 4 + hh], l2 = LSE[((size_t)2 * MP + tok) * 4 + hh];
          const float m = fmaxf(l0, fmaxf(l1, l2)); float w0 = __expf(l0 - m), w1 = __expf(l1 - m), w2 = __expf(l2 - m); const float inv = 1.f / (w0 + w1 + w2); w0 *= inv; w1 *= inv; w2 *= inv;
          const u32x2 a0 = *(const u32x2*)(PA + (size_t)tok * NPA + col), a1 = *(const u32x2*)(PA + (size_t)tok * NPA + 256 + col), a2 = *(const u32x2*)(PA + (size_t)tok * NPA + 512 + col);
          u32x2 o; o.x = cvt_pk_bf16(w0 * bf_lo(a0.x) + w1 * bf_lo(a1.x) + w2 * bf_lo(a2.x), w0 * bf_hi(a0.x) + w1 * bf_hi(a1.x) + w2 * bf_hi(a2.x));
          o.y = cvt_pk_bf16(w0 * bf_lo(a0.y) + w1 * bf_lo(a1.y) + w2 * bf_lo(a2.y), w0 * bf_hi(a0.y) + w1 * bf_hi(a1.y) + w2 * bf_hi(a2.y));
          *(u32x2*)(OA + (size_t)tok * 256 + col) = o; }
        { const int col = 16 * lane;
          float ov[16], zv[16];
          { const u32x4 w0 = *(const u32x4*)(PA + (size_t)tok * NPA + PA_QB + col), w1 = *(const u32x4*)(PA + (size_t)tok * NPA + PA_QB + col + 8); float t0[8], t1[8]; unpack8(w0, t0); unpack8(w1, t1);
#pragma unroll
            for (int e = 0; e < 8; ++e) { ov[e] = t0[e]; ov[8 + e] = t1[e]; } }
          { const u32x4 w0 = *(const u32x4*)(PB + (size_t)tok * NPB + PB_Z + col), w1 = *(const u32x4*)(PB + (size_t)tok * NPB + PB_Z + col + 8); float t0[8], t1[8]; unpack8(w0, t0); unpack8(w1, t1);
#pragma unroll
            for (int e = 0; e < 8; ++e) { zv[e] = t0[e]; zv[8 + e] = t1[e]; } }
          float ss = 0.f;
#pragma unroll
          for (int e = 0; e < 16; ++e) ss += ov[e] * ov[e];
          ss += __shfl_xor(ss, 1); ss += __shfl_xor(ss, 2); ss += __shfl_xor(ss, 4);
          const float rs = rsqrtf(ss * (1.f / 128.f) + EPS);
          const float* gn = MK_IN(17) + (col & 127);
          float r[16];
#pragma unroll
          for (int e = 0; e < 16; ++e) r[e] = ov[e] * rs * gn[e] * siluf_(zv[e]);
          u32x4 o0, o1; o0.x = cvt_pk_bf16(r[0], r[1]); o0.y = cvt_pk_bf16(r[2], r[3]); o0.z = cvt_pk_bf16(r[4], r[5]); o0.w = cvt_pk_bf16(r[6], r[7]);
          o1.x = cvt_pk_bf16(r[8], r[9]); o1.y = cvt_pk_bf16(r[10], r[11]); o1.z = cvt_pk_bf16(r[12], r[13]); o1.w = cvt_pk_bf16(r[14], r[15]);
          *(u32x4*)(OB + (size_t)tok * D + col) = o0; *(u32x4*)(OB + (size_t)tok * D + col + 8) = o1; }
    }
}

__device__ __forceinline__ void p11_act(CArgs* A, const Ctx& C) {
    const bf16_t* GU = wsp<bf16_t>(C, WS_GU); bf16_t* ACT = wsp<bf16_t>(C, WS_ACT);
    const float* wc = MK_IN(28); const float* bc = MK_IN(29);
    constexpr int NCG = FF / 8;
    for (int it = C.gtid; it < (MP / 8) * NCG; it += C.NGT) { const int rb = it / NCG, cgp = it % NCG, c = cgp * 8, row0 = rb * 8; const bool first = (row0 % SEQ) == 0;
        float w0[8], w1[8], w2[8], bb[8];
#pragma unroll
        for (int e = 0; e < 8; ++e) { w0[e] = wc[c + e]; w1[e] = wc[FF + c + e]; w2[e] = wc[2 * FF + c + e]; bb[e] = bc[c + e]; }
        float g0[8], g1[8], g2[8];
        if (first) {
#pragma unroll
            for (int e = 0; e < 8; ++e) { g0[e] = 0.f; g1[e] = 0.f; } }
        else { unpack8(*(const u32x4*)(GU + (size_t)(row0 - 2) * NUP + c), g0); unpack8(*(const u32x4*)(GU + (size_t)(row0 - 1) * NUP + c), g1); }
#pragma unroll
        for (int r = 0; r < 8; ++r) { float up[8]; unpack8(*(const u32x4*)(GU + (size_t)(row0 + r) * NUP + c), g2); unpack8(*(const u32x4*)(GU + (size_t)(row0 + r) * NUP + FF + c), up);
            float o[8];
#pragma unroll
            for (int e = 0; e < 8; ++e) { const float a = w0[e] * g0[e] + w1[e] * g1[e] + w2[e] * g2[e] + bb[e]; o[e] = siluf_(a) * up[e]; g0[e] = g1[e]; g1[e] = g2[e]; }
            u32x4 w; w.x = cvt_pk_bf16(o[0], o[1]); w.y = cvt_pk_bf16(o[2], o[3]); w.z = cvt_pk_bf16(o[4], o[5]); w.w = cvt_pk_bf16(o[6], o[7]);
            *(u32x4*)(ACT + (size_t)(row0 + r) * FF + c) = w; } }
    for (int it = C.gtid; it < SB * NCG; it += C.NGT) { const int b = it / NCG, cgp = it % NCG, c = cgp * 8;
        float w0[8], w1[8], w2[8], bb[8], g0[8], g1[8], g2[8];
#pragma unroll
        for (int e = 0; e < 8; ++e) { w0[e] = wc[c + e]; w1[e] = wc[FF + c + e]; w2[e] = wc[2 * FF + c + e]; bb[e] = bc[c + e]; g0[e] = MK_IN(9)[(size_t)(b * 2) * FF + c + e]; g1[e] = MK_IN(9)[(size_t)(b * 2 + 1) * FF + c + e]; }
#pragma unroll
        for (int t = 0; t < 4; ++t) { const size_t row = (size_t)(MP + b * 4 + t); float up[8]; unpack8(*(const u32x4*)(GU + row * NUP + c), g2); unpack8(*(const u32x4*)(GU + row * NUP + FF + c), up);
            float o[8];
#pragma unroll
            for (int e = 0; e < 8; ++e) { const float a = w0[e] * g0[e] + w1[e] * g1[e] + w2[e] * g2[e] + bb[e]; o[e] = siluf_(a) * up[e]; g0[e] = g1[e]; g1[e] = g2[e]; }
            u32x4 w; w.x = cvt_pk_bf16(o[0], o[1]); w.y = cvt_pk_bf16(o[2], o[3]); w.z = cvt_pk_bf16(o[4], o[5]); w.w = cvt_pk_bf16(o[6], o[7]);
            *(u32x4*)(ACT + row * FF + c) = w; } }
    for (int it = C.gtid; it < NB * 2 * NCG; it += C.NGT) { const int bi = it / NCG, c = (it % NCG) * 8, b = bi >> 1, i = bi & 1; cp8(GU + (size_t)(b * SEQ + SEQ - 2 + i) * NUP + c, C.out + O_FCONVP + (size_t)bi * FF + c); }
    for (int it = C.gtid; it < SB * 2 * NCG; it += C.NGT) { const int bi = it / NCG, c = (it % NCG) * 8, b = bi >> 1, i = bi & 1; cp8(GU + (size_t)(MP + b * 4 + 2 + i) * NUP + c, C.out + O_FCONVS + (size_t)bi * FF + c); }
}
__device__ __forceinline__ void p13_final(CArgs* A, const Ctx& C) {
    const f32x4* gr = (const f32x4*)MK_IN(31) + C.lane;
    for (int m = C.gw; m < MV; m += C.NGW) { f32x4* xr = (f32x4*)(C.out + (size_t)m * D) + C.lane; f32x4 v[4]; float s = 0.f;
#pragma unroll
        for (int j = 0; j < 4; ++j) { v[j] = xr[64 * j]; s += (v[j].x * v[j].x + v[j].y * v[j].y) + (v[j].z * v[j].z + v[j].w * v[j].w); }
        const float rs = rsqrtf(wave_sum(s) * (1.f / D) + EPS);
#pragma unroll
        for (int j = 0; j < 4; ++j) xr[64 * j] = v[j] * rs * gr[64 * j]; }
}

#ifndef MK_PER_PHASE
#define MK_PER_PHASE 0
#endif
constexpr int N_PHASES = 14;

#define PH_REFRESH0() do { A = (CArgs*)__builtin_amdgcn_kernarg_segment_ptr(); asm volatile("" : "+s"(A)); C.ws = A->ws; C.out = A->out; C.ctl = (unsigned*)C.ws; } while (0)
template <int ONLY> __global__ void __launch_bounds__(NTHR, 2) mk_fwd(Args args) {
    extern __shared__ __attribute__((aligned(16))) unsigned char lds_raw[];
    Ctx C;
    C.lds = (LAS unsigned char*)lds_raw; C.MISC = (volatile LAS unsigned*)(C.lds + MISC_OFF);
    C.tid = threadIdx.x; C.lane = C.tid & 63; C.wave = __builtin_amdgcn_readfirstlane(C.tid >> 6);
    C.G = gridDim.x; C.gw = blockIdx.x * NWAVES + C.wave; C.NGW = C.G * NWAVES; C.gtid = blockIdx.x * NTHR + C.tid; C.NGT = C.G * NTHR;
    CArgs* A; PH_REFRESH0();
    for (int u = C.tid; u < (LDS_BYTES - LDSCTL_OFF) / 4; u += NTHR) ((LAS unsigned*)(C.lds + LDSCTL_OFF))[u] = 0u;
    __syncthreads();
    XcdBarrier bar; bar.bar = C.ctl + CW_BAR; bar.x = 0; bar.st = nullptr;
    if (ONLY < 0) bar = xcd_barrier_post(C.ctl + CW_BAR, C.MISC + 8);
    const int lo = A->ph_lo, hi = A->ph_hi;
#define IN_PH(k) ((ONLY < 0 || ONLY == (k)) && lo <= (k) && (k) < hi)
#define SEAM(k) do { if (IN_PH(k) && IN_PH((k) + 1)) xcd_barrier(bar); } while (0)
    LAS unsigned char* ring = C.lds;
    const int bid = blockIdx.x;
#define PH_REFRESH() do { A = (CArgs*)__builtin_amdgcn_kernarg_segment_ptr(); asm volatile("" : "+s"(A)); C.ws = A->ws; C.out = A->out; C.ctl = (unsigned*)C.ws; } while (0)
#define XN_ wsp<bf16_t>(C, WS_XN)
#define PA_ wsp<bf16_t>(C, WS_R1)
#define PB_ wsp<bf16_t>(C, WS_R2)
#define HB_ wsp<bf16_t>(C, WS_HB)
#define T1_ wsp<bf16_t>(C, WS_T1)
#define SSQ1_ ((float*)(C.ws + WS_CTL + CTL_SSQ1))
#define SSQ2_ ((float*)(C.ws + WS_CTL + CTL_SSQ2))

    if (IN_PH(0)) { PH_REFRESH(); p0_prologue(A, C); } SEAM(0);
    if (IN_PH(1)) { PH_REFRESH();
        { pg8::Gemm g{XN_, wsp<bf16_t>(C, WS_WIN), MT, NIN, D}; pg8::StaticOrder S; S.init(MT, NIN, C.G, bid); EpiProj E{PA_, PB_};
          pg8::gemm_phase<EpiProj, pg8::StaticOrder, true, true>(ring, g, S, E); }
        { pg8::Gemm g{wsp<bf16_t>(C, WS_MN), wsp<bf16_t>(C, WS_WMKV), 2048, D, D}; pg8::StaticOrder S; S.init(2048, D, C.G, (bid + 128) % C.G); EpiMemKV E{wsp<bf16_t>(C, WS_MEMKV), C.out + O_MEMKP, C.out + O_MEMVP};
          pg8::gemm_phase<EpiMemKV, pg8::StaticOrder, true, true>(ring, g, S, E); }
    } SEAM(1);
    if (IN_PH(2)) { PH_REFRESH(); for (int u = bid; u < 256; u += C.G) gdn_prep_unit(A, C, u); p2_state_copies(A, C); } SEAM(2);
    if (IN_PH(3)) { PH_REFRESH();
        for (int u = bid; u < 64; u += C.G) gdn_scan_unit(A, C, u);
        for (;;) { const int u = next_unit(C, CW_Q0); if (u >= 1536 + 128 + 256) break;
            if (u < 1536) dil_attn_unit(A, C, u); else if (u < 1664) dil_sample_unit(A, C, u - 1536); else gdn_sample_unit(A, C, u - 1664); }
    } SEAM(3);
#if defined(MK_DUMP) && MK_DUMP == 3
    if (IN_PH(4)) {   PH_REFRESH();
#if MK_DUMPSEL == 16
        for (int i = C.gtid; i < MP * 128; i += C.NGT) { const int row = i >> 7, c = (i & 127) * 8; cp8(PA_ + (size_t)row * NPA + PA_QB + c, C.out + (size_t)row * D + c); }
#elif MK_DUMPSEL == 64
        for (int i = C.gtid; i < 2048 * 1024; i += C.NGT) { const int ch = i >> 10, p = i & 1023; cp8((const bf16_t*)(wsp<unsigned char>(C, WS_R3) + (size_t)ch * CH_STRIDE + 16384) + p * 8, C.out + (size_t)i * 8); }
#elif MK_DUMPSEL == 128
        for (int i = C.gtid; i < 2048 * 1024; i += C.NGT) { const int ch = i >> 10, p = i & 1023; cp8((const bf16_t*)(wsp<unsigned char>(C, WS_R3) + (size_t)ch * CH_STRIDE + 49152) + p * 8, C.out + (size_t)i * 8); }
#elif MK_DUMPSEL == 32
        for (int i = C.gtid; i < MP * 12; i += C.NGT) { const int row = i / 12, k = i % 12; C.out[(size_t)row * D + k] = wsp<float>(C, WS_LSE)[((size_t)(k >> 2) * MP + row) * 4 + (k & 3)]; }
#else
        for (int i = C.gtid; i < MV * 128; i += C.NGT) { const int row = i >> 7, c = (i & 127) * 8; const bf16_t* src;
            if (row < MP) src = (c < 768) ? PA_ + (size_t)row * NPA + c : PA_ + (size_t)row * NPA + PA_QB + (c - 768);
            else src = (c < 256) ? wsp<bf16_t>(C, WS_OA) + (size_t)row * 256 + c : XN_ + (size_t)row * D + (c - 256);
            const int sel = (row < MP) ? ((c < 768) ? 1 : 2) : ((c < 256) ? 4 : 8);
            if (sel & MK_DUMPSEL) cp8(src, C.out + (size_t)row * D + c); else { *(f32x4*)(C.out + (size_t)row * D + c) = (f32x4){0.f,0.f,0.f,0.f}; *(f32x4*)(C.out + (size_t)row * D + c + 4) = (f32x4){0.f,0.f,0.f,0.f}; } }
#endif
    }
#endif
    if (IN_PH(4)) { PH_REFRESH(); p4_merge(A, C); } SEAM(4);
    if (IN_PH(5)) { PH_REFRESH();
        { pg8::Gemm g{wsp<bf16_t>(C, WS_OA), wsp<bf16_t>(C, WS_WA), MT, D, 256}; pg8::StaticOrder S; S.init(MT, D, C.G, bid); EpiBranch<false> E{T1_, PB_};
          pg8::gemm_phase<EpiBranch<false>, pg8::StaticOrder, true, true>(ring, g, S, E); }
        { pg8::Gemm g{XN_, wsp<bf16_t>(C, WS_WB), MT, D, D}; pg8::StaticOrder S; S.init(MT, D, C.G, bid); EpiBranch<true> E{T1_, PB_};
          pg8::gemm_phase<EpiBranch<true>, pg8::StaticOrder, true, true>(ring, g, S, E); }
    } SEAM(5);
    if (IN_PH(6)) { PH_REFRESH(); pg8::Gemm g{T1_, wsp<bf16_t>(C, WS_WOUT), MT, D, D}; pg8::StaticOrder S; S.init(MT, D, C.G, bid); EpiResid<true, true, true> E{A->in[0], A->in[1], C.out, HB_, SSQ1_};
        pg8::gemm_phase<EpiResid<true, true, true>, pg8::StaticOrder, true, true>(ring, g, S, E); } SEAM(6);
    if (IN_PH(7)) { PH_REFRESH(); pg8::Gemm g{HB_, wsp<bf16_t>(C, WS_WMQ), MT, 512, D}; pg8::StaticOrder S; S.init(MT, 512, C.G, bid); EpiScale E{wsp<bf16_t>(C, WS_QM), 512, SSQ1_};
        pg8::gemm_phase<EpiScale, pg8::StaticOrder, true, true>(ring, g, S, E); } SEAM(7);
    if (IN_PH(8)) { PH_REFRESH();
        { u32x4* z = (u32x4*)(wsp<bf16_t>(C, WS_OM) + (size_t)MV * 512); const int n16 = (MT - MV) * 512 * 2 / 16; for (int i = C.gtid; i < n16; i += C.NGT) z[i] = (u32x4){0u, 0u, 0u, 0u}; }
        for (;;) { const int u = next_unit(C, CW_Q1); if (u >= 256 + 128) break; if (u < 256) cross_attn_unit(A, C, u); else cross_sample_unit(A, C, u - 256); }
    } SEAM(8);
    if (IN_PH(9)) { PH_REFRESH(); pg8::Gemm g{wsp<bf16_t>(C, WS_OM), wsp<bf16_t>(C, WS_WMO), MT, D, 512}; pg8::StaticOrder S; S.init(MT, D, C.G, bid); EpiResid<false, true, true> E{nullptr, nullptr, C.out, HB_, SSQ2_};
        pg8::gemm_phase<EpiResid<false, true, true>, pg8::StaticOrder, true, true>(ring, g, S, E); } SEAM(9);
    if (IN_PH(10)) { PH_REFRESH(); pg8::Gemm g{HB_, wsp<bf16_t>(C, WS_WUP), MT, NUP, D}; pg8::StaticOrder S; S.init(MT, NUP, C.G, bid); EpiScale E{wsp<bf16_t>(C, WS_GU), NUP, SSQ2_};
        pg8::gemm_phase<EpiScale, pg8::StaticOrder, true, true>(ring, g, S, E); } SEAM(10);
    if (IN_PH(11)) { PH_REFRESH(); p11_act(A, C); } SEAM(11);
    if (IN_PH(12)) { PH_REFRESH(); pg8::Gemm g{wsp<bf16_t>(C, WS_ACT), wsp<bf16_t>(C, WS_WDN), MT, D, FF}; pg8::StaticOrder S; S.init(MT, D, C.G, bid); EpiResid<false, false, false> E{nullptr, nullptr, C.out, nullptr, nullptr};
        pg8::gemm_phase<EpiResid<false, false, false>, pg8::StaticOrder, true, true>(ring, g, S, E); } SEAM(12);
    if (IN_PH(13)) { PH_REFRESH(); p13_final(A, C); }
#undef IN_PH
#undef SEAM
}
}


#ifndef MK_STOP_AFTER
#define MK_STOP_AFTER 13
#endif
#if MK_PER_PHASE
template <int P> static hipError_t set_lds_attr_p() { if (hipFuncSetAttribute((const void*)mk::mk_fwd<P>, hipFuncAttributeMaxDynamicSharedMemorySize, mk::LDS_BYTES) != hipSuccess) return hipErrorUnknown; if constexpr (P + 1 < mk::N_PHASES) return set_lds_attr_p<P + 1>(); else return hipSuccess; }
static hipError_t set_lds_attr() { return set_lds_attr_p<0>(); }
template <int P> static void launch_phases(mk::Args a, int grid, hipStream_t stream) { a.ph_lo = P; a.ph_hi = P + 1; a.li = 0; hipLaunchKernelGGL(mk::mk_fwd<P>, dim3(grid), dim3(mk::NTHR), mk::LDS_BYTES, stream, a); if constexpr (P + 1 < mk::N_PHASES && P + 1 <= MK_STOP_AFTER) launch_phases<P + 1>(a, grid, stream); }
#else
static hipError_t set_lds_attr() { return hipFuncSetAttribute((const void*)mk::mk_fwd<-1>, hipFuncAttributeMaxDynamicSharedMemorySize, mk::LDS_BYTES); }
#endif
extern "C" void kernel_launch(void* const* d_in, const int* in_sizes, int n_in, void* d_out, int out_size, void* d_ws, size_t ws_size, hipStream_t stream) {
    using namespace mk;
    static int grid = 0;
    if (grid == 0) {
        if (n_in != 32 || (size_t)out_size != O_END || ws_size < WS_END) { fprintf(stderr, "kernel_launch: unexpected problem: n_in %d out_size %d (want %zu) ws %zu (want >= %zu); nothing launched\n", n_in, out_size, (size_t)O_END, ws_size, (size_t)WS_END); grid = -1; return; }
        int dev = 0, cus = 0, per_cu = 0;
        if (hipGetDevice(&dev) != hipSuccess || hipDeviceGetAttribute(&cus, hipDeviceAttributeMultiprocessorCount, dev) != hipSuccess) { grid = -1; return; }
        if (set_lds_attr() != hipSuccess) { fprintf(stderr, "kernel_launch: hipFuncSetAttribute failed\n"); grid = -1; return; }
        if (hipOccupancyMaxActiveBlocksPerMultiprocessor(&per_cu, (const void*)mk_fwd<MK_PER_PHASE ? 1 : -1>, NTHR, LDS_BYTES) != hipSuccess || per_cu < 1) fprintf(stderr, "kernel_launch: occupancy query says %d blocks per CU\n", per_cu);
        (void)hipGetLastError();
        grid = cus;
    }
    if (grid < 0) return;
    if (hipMemsetAsync((char*)d_ws + WS_CTL, 0, CTL_ZERO_BYTES, stream) != hipSuccess) { fprintf(stderr, "kernel_launch: memset failed\n"); return; }
    Args a{};
    for (int i = 0; i < 32; ++i) a.in[i] = (const float*)d_in[i];
    a.out = (float*)d_out; a.ws = (unsigned char*)d_ws;
#if MK_PER_PHASE
    launch_phases<0>(a, grid, stream);
#else
    a.ph_lo = 0; a.ph_hi = N_PHASES; a.li = 0;
    hipLaunchKernelGGL(mk_fwd<-1>, dim3(grid), dim3(NTHR), LDS_BYTES, stream, a);
#endif
    const hipError_t le = hipPeekAtLastError();
    if (le != hipSuccess) fprintf(stderr, "kernel_launch: launch failed: %s\n", hipGetErrorName(le));
}
```

```cpp
#include <hip/hip_runtime.h>
#include <cstdio>
#include <cstdint>
#ifndef MK_SCAN_COPY
#define MK_SCAN_COPY 1
#endif
namespace pg8 {
#define PG8_LAS __attribute__((address_space(3)))
typedef unsigned short bf16_t;
typedef short bf16x8 __attribute__((ext_vector_type(8)));
typedef float f32x4 __attribute__((ext_vector_type(4)));
typedef unsigned u32x4 __attribute__((ext_vector_type(4)));
constexpr int BM = 256, BK = 64, HALF = 128, HTB = HALF * BK * 2  , STAGE_BYTES = 8 * HTB, NXCD = 8, WGM = 8;

__host__ __device__ __forceinline__ int lds_byte(int r, int c) { const int st = (r >> 4) * 2 + (c >> 5), rr = r & 15, cc = c & 31, ob = rr * 64 + cc * 2; return st * 1024 + (ob ^ (((ob >> 9) & 1) << 5)); }
__host__ __device__ __forceinline__ void stage_rc(int b, int& R, int& C) { const int st = b / 1024, sb = b % 1024, swz = sb ^ (((sb >> 9) & 1) << 5); R = (st >> 1) * 16 + swz / 64; C = (st & 1) * 32 + (swz % 64) / 2; }
__host__ __device__ __forceinline__ int perm32(int rho) { const int n = rho >> 4, i = rho & 15; return 8 * (i >> 2) + 4 * n + (i & 3); }

struct Unit { int pm, pn; };
struct Gemm { const bf16_t* A; const bf16_t* Bt; int M, N, K; };

struct StaticOrder {
    int nM, nN, nwg, G, c;
    __host__ __device__ void init(int M, int N, int G_, int c_) { nM = M / BM; nN = N / BM; nwg = nM * nN; G = G_; c = c_; }
    __host__ __device__ bool next(int i, Unit& u) const {
        const long L = (long)i * G + c; if (L >= nwg) return false;
        int wgid = (int)L; { const int q = nwg / NXCD, r = nwg % NXCD, xcd = wgid % NXCD, off = wgid / NXCD; wgid = (xcd < r ? xcd * (q + 1) : r * (q + 1) + (xcd - r) * q) + off; }
        const int nig = WGM * nN, gid = wgid / nig, fm = gid * WGM, gsz = (nM - fm) < WGM ? (nM - fm) : WGM;
        u.pm = fm + ((wgid % nig) % gsz); u.pn = (wgid % nig) / gsz; return true;
    }
    __device__ __forceinline__ void a_ready(const Unit&) const {}
    __device__ __forceinline__ void done(const Unit&) const {}
};
template <class Epi, class Sched, bool ALIGN_EPI = false, bool SP2 = false>
__device__ __forceinline__ void gemm_phase(PG8_LAS unsigned char* lds, const Gemm g, const Sched& S, const Epi& E) {
    int tid_ = threadIdx.x; asm volatile("" : "+v"(tid_));
    const int tid = tid_, wid = __builtin_amdgcn_readfirstlane(tid >> 6), lane = tid & 63, wr = wid >> 2, wc = wid & 3, fr = lane & 15, fq = lane >> 4;
    const int K = g.K, nt = K / BK;
    unsigned voffA[2], voffB[2];
#pragma unroll
    for (int i = 0; i < 2; ++i) { int R, C; stage_rc(tid * 16 + i * 8192, R, C); const int Rb = Epi::PERM ? ((R & ~31) + perm32(R & 31)) : R;
        voffA[i] = (unsigned)(R * K + C) * 2u; voffB[i] = (unsigned)(Rb * K + C) * 2u; }
    const size_t kstep = (size_t)(BK * 2);
    const size_t hstep = (size_t)HALF * K * 2;
    const size_t tstep = 2 * hstep;
    const unsigned ldsw = (unsigned)wid * 1024u;
    const int aoff = lds_byte(wr * 64 + fr, fq * 8), boff = lds_byte(wc * 32 + fr, fq * 8);
#define PG8_SA(b, h) (((b) * 2 + (h)) * HTB)
#define PG8_SB(b, h) ((4 + (b) * 2 + (h)) * HTB)
#define PG8_STAGE(bufoff, gbase, voff) do { _Pragma("unroll") for (int _i = 0; _i < 2; ++_i) \
        __builtin_amdgcn_global_load_lds((const unsigned*)((const char*)(gbase) + (voff)[_i]), (PG8_LAS unsigned*)(lds + (bufoff) + ldsw + _i * 8192), 16, 0, 0); } while (0)
#define PG8_LDA(dst, b, h) do { _Pragma("unroll") for (int m = 0; m < 4; ++m) _Pragma("unroll") for (int k = 0; k < 2; ++k) dst[m][k] = *(const PG8_LAS bf16x8*)(lds + PG8_SA(b, h) + aoff + m * 2048 + k * 1024); } while (0)
#define PG8_LDB(dst, b, h) do { _Pragma("unroll") for (int n = 0; n < 2; ++n) _Pragma("unroll") for (int k = 0; k < 2; ++k) dst[n][k] = *(const PG8_LAS bf16x8*)(lds + PG8_SB(b, h) + boff + n * 2048 + k * 1024); } while (0)
#define PG8_MMA(ai, bj, At, Bt) do { __builtin_amdgcn_s_setprio(1); _Pragma("unroll") for (int m = 0; m < 4; ++m) _Pragma("unroll") for (int n = 0; n < 2; ++n) _Pragma("unroll") for (int k = 0; k < 2; ++k) \
        acc[ai][bj][m][n] = __builtin_amdgcn_mfma_f32_16x16x32_bf16(Bt[n][k], At[m][k], acc[ai][bj][m][n], 0, 0, 0); __builtin_amdgcn_s_setprio(0); } while (0)
#define PG8_WAIT_V(n) asm volatile("s_waitcnt vmcnt(" #n ")" ::: "memory")
#define PG8_WAIT_L(n) asm volatile("s_waitcnt lgkmcnt(" #n ")" ::: "memory")
#define PG8_BAR __builtin_amdgcn_s_barrier()
#define PG8_SCHED __builtin_amdgcn_sched_barrier(0)
    Unit cur, nxt; int ui = 0;
    if (!S.next(0, cur)) return;
    f32x4 acc[2][2][4][2];
#pragma unroll
    for (int a = 0; a < 2; ++a)
#pragma unroll
        for (int b = 0; b < 2; ++b)
#pragma unroll
            for (int m = 0; m < 4; ++m)
#pragma unroll
                for (int n = 0; n < 2; ++n) acc[a][b][m][n] = (f32x4){0.f, 0.f, 0.f, 0.f};
    bf16x8 At[4][2], B0[2][2], B1[2][2];
    const char* cA = (const char*)g.A + (size_t)cur.pm * tstep; const char* cB = (const char*)g.Bt + (size_t)cur.pn * tstep;
    S.a_ready(cur);
    if constexpr (SP2) {
        PG8_STAGE(PG8_SB(0, 0), cB, voffB); PG8_STAGE(PG8_SB(0, 1), cB + hstep, voffB); PG8_STAGE(PG8_SA(0, 0), cA, voffA); PG8_STAGE(PG8_SA(0, 1), cA + hstep, voffA);
        if (wr == 1) PG8_BAR;
        PG8_WAIT_V(2); PG8_BAR;
        PG8_STAGE(PG8_SB(1, 0), cB + kstep, voffB); PG8_STAGE(PG8_SA(1, 0), cA + kstep, voffA); PG8_STAGE(PG8_SB(1, 1), cB + hstep + kstep, voffB);
        PG8_WAIT_V(6); PG8_BAR;
    } else {
        PG8_STAGE(PG8_SB(0, 0), cB, voffB); PG8_STAGE(PG8_SA(0, 0), cA, voffA); PG8_STAGE(PG8_SB(0, 1), cB + hstep, voffB); PG8_STAGE(PG8_SA(0, 1), cA + hstep, voffA);
        if (wr == 1) PG8_BAR;
        PG8_WAIT_V(4); PG8_BAR;
        PG8_STAGE(PG8_SB(1, 0), cB + kstep, voffB); PG8_STAGE(PG8_SA(1, 0), cA + kstep, voffA); PG8_STAGE(PG8_SB(1, 1), cB + hstep + kstep, voffB);
        PG8_WAIT_V(6); PG8_BAR;
    }
    for (;;) {
        const bool has_next = S.next(ui + 1, nxt);
        const char* nA = has_next ? (const char*)g.A + (size_t)nxt.pm * tstep : cA; const char* nB = has_next ? (const char*)g.Bt + (size_t)nxt.pn * tstep : cB;
        for (int t = 0; t < nt; t += 2) {
            const bool last = (t == nt - 2);
            const char* a1 = cA + (size_t)(t + 1) * kstep;
            const char* a2 = last ? nA : cA + (size_t)(t + 2) * kstep; const char* b2 = last ? nB : cB + (size_t)(t + 2) * kstep;
            const char* a3 = a2 + kstep; const char* b3 = b2 + kstep;
            if (last && has_next) S.a_ready(nxt);
            if constexpr (SP2) {
            PG8_LDB(B0, 0, 0); PG8_LDB(B1, 0, 1); PG8_SCHED; PG8_LDA(At, 0, 0); PG8_STAGE(PG8_SA(1, 1), a1 + hstep, voffA);
            PG8_WAIT_V(8); PG8_WAIT_L(0); PG8_BAR; PG8_MMA(0, 0, At, B0); PG8_MMA(0, 1, At, B1); PG8_BAR; PG8_SCHED;
            PG8_LDA(At, 0, 1); PG8_STAGE(PG8_SB(0, 0), b2, voffB); PG8_STAGE(PG8_SB(0, 1), b2 + hstep, voffB); PG8_STAGE(PG8_SA(0, 0), a2, voffA);
            PG8_WAIT_V(8); PG8_WAIT_L(0); PG8_BAR; PG8_MMA(1, 0, At, B0); PG8_MMA(1, 1, At, B1); PG8_BAR; PG8_SCHED;
            PG8_LDB(B0, 1, 0); PG8_LDB(B1, 1, 1); PG8_SCHED; PG8_LDA(At, 1, 0); PG8_STAGE(PG8_SA(0, 1), a2 + hstep, voffA);
            PG8_WAIT_V(8); PG8_WAIT_L(0); PG8_BAR; PG8_MMA(0, 0, At, B0); PG8_MMA(0, 1, At, B1); PG8_BAR; PG8_SCHED;
            PG8_LDA(At, 1, 1); PG8_STAGE(PG8_SB(1, 0), b3, voffB); PG8_STAGE(PG8_SB(1, 1), b3 + hstep, voffB); PG8_STAGE(PG8_SA(1, 0), a3, voffA);
            PG8_WAIT_V(8); PG8_WAIT_L(0); PG8_BAR; PG8_MMA(1, 0, At, B0); PG8_MMA(1, 1, At, B1); PG8_BAR; PG8_SCHED;
            } else {
            PG8_LDB(B0, 0, 0); PG8_SCHED; PG8_LDA(At, 0, 0); PG8_STAGE(PG8_SA(1, 1), a1 + hstep, voffA);
            PG8_WAIT_L(8); PG8_BAR; PG8_WAIT_L(0); PG8_MMA(0, 0, At, B0); PG8_BAR; PG8_SCHED;
            PG8_LDB(B1, 0, 1); PG8_STAGE(PG8_SB(0, 0), b2, voffB);
            PG8_BAR; PG8_WAIT_L(0); PG8_MMA(0, 1, At, B1); PG8_BAR;
            PG8_LDA(At, 0, 1); PG8_STAGE(PG8_SA(0, 0), a2, voffA);
            PG8_BAR; PG8_WAIT_L(0); PG8_MMA(1, 0, At, B0); PG8_BAR; PG8_SCHED;
            PG8_STAGE(PG8_SB(0, 1), b2 + hstep, voffB);
            PG8_WAIT_V(6); PG8_BAR; PG8_MMA(1, 1, At, B1); PG8_BAR;
            PG8_LDB(B0, 1, 0); PG8_SCHED; PG8_LDA(At, 1, 0); PG8_STAGE(PG8_SA(0, 1), a2 + hstep, voffA);
            PG8_WAIT_L(8); PG8_BAR; PG8_WAIT_L(0); PG8_MMA(0, 0, At, B0); PG8_BAR; PG8_SCHED;
            PG8_LDB(B1, 1, 1); PG8_STAGE(PG8_SB(1, 0), b3, voffB);
            PG8_BAR; PG8_WAIT_L(0); PG8_MMA(0, 1, At, B1); PG8_BAR;
            PG8_LDA(At, 1, 1); PG8_STAGE(PG8_SA(1, 0), a3, voffA);
            PG8_BAR; PG8_WAIT_L(0); PG8_MMA(1, 0, At, B0); PG8_BAR; PG8_SCHED;
            PG8_STAGE(PG8_SB(1, 1), b3 + hstep, voffB);
            PG8_WAIT_V(6); PG8_BAR; PG8_MMA(1, 1, At, B1); PG8_BAR;
            }
        }
        if constexpr (ALIGN_EPI) { if (wr == 0) PG8_BAR; }
        if constexpr (!Epi::AFTER_DRAIN) { E(acc, cur, wr, wc, fr, fq); S.done(cur); }
        if (!has_next) break;
#pragma unroll
        for (int a = 0; a < 2; ++a)
#pragma unroll
            for (int b = 0; b < 2; ++b)
#pragma unroll
                for (int m = 0; m < 4; ++m)
#pragma unroll
                    for (int n = 0; n < 2; ++n) acc[a][b][m][n] = (f32x4){0.f, 0.f, 0.f, 0.f};
        cur = nxt; cA = nA; cB = nB; ++ui;
        if constexpr (ALIGN_EPI) { if (wr == 1) PG8_BAR; }
    }
    PG8_WAIT_V(0);
    if constexpr (!ALIGN_EPI) { if (wr == 0) PG8_BAR; }
    PG8_BAR;
    if constexpr (Epi::AFTER_DRAIN) { E.fused(acc, cur, wr, wc, fr, fq, lds, wid, lane); S.done(cur); }
#undef PG8_SA
#undef PG8_SB
#undef PG8_STAGE
#undef PG8_LDA
#undef PG8_LDB
#undef PG8_MMA
#undef PG8_WAIT_V
#undef PG8_WAIT_L
#undef PG8_BAR
#undef PG8_SCHED
}
}

#define LAS __attribute__((address_space(3)))
#define GAS __attribute__((address_space(1)))
namespace mk {
typedef unsigned short bf16_t;
typedef short bf16x8 __attribute__((ext_vector_type(8)));
typedef float f32x4 __attribute__((ext_vector_type(4)));
typedef unsigned u32x4 __attribute__((ext_vector_type(4)));
typedef unsigned u32x2 __attribute__((ext_vector_type(2)));
typedef GAS unsigned gu32;

constexpr int NWAVES = 8, NTHR = 512;
constexpr int D = 1024, NB = 8, SEQ = 2048, MP = NB * SEQ, SB = 32, ST = 4, MS = SB * ST, MV = MP + MS, MT = 16640;
constexpr int NPA = 5376, NPB = 3328, NIN = 8704, FF = 2816, NUP = 2 * FF;
constexpr int PA_QA = 0, PA_KA = 768, PA_VA = 1536, PA_QB = 2304;
constexpr int PB_Z = 0, PB_GA = 1024, PB_GB = 2048, PB_BETA = 3072, PB_A = 3080;
constexpr int PAST = 8192;
constexpr float EPS = 1e-6f;

constexpr size_t O_Y = 0;
constexpr size_t O_YS = O_Y + (size_t)MP * D;
constexpr size_t O_DIL0P = O_YS + (size_t)MS * D;
constexpr size_t O_DIL1P = O_DIL0P + (size_t)NB * 128 * 512;
constexpr size_t O_DIL2P = O_DIL1P + (size_t)NB * 512 * 512;
constexpr size_t O_DSTP = O_DIL2P + (size_t)NB * 2048 * 512;
constexpr size_t O_DCONVP = O_DSTP + (size_t)NB * 8 * 128 * 128;
constexpr size_t O_MEMKP = O_DCONVP + (size_t)NB * 3 * 3072;
constexpr size_t O_MEMVP = O_MEMKP + (size_t)NB * 256 * 512;
constexpr size_t O_FCONVP = O_MEMVP + (size_t)NB * 256 * 512;
constexpr size_t O_DIL0S = O_FCONVP + (size_t)NB * 2 * FF;
constexpr size_t O_DIL1S = O_DIL0S + (size_t)SB * 128 * 512;
constexpr size_t O_DIL2S = O_DIL1S + (size_t)SB * 512 * 512;
constexpr size_t O_DSTS = O_DIL2S + (size_t)SB * 2048 * 512;
constexpr size_t O_DCONVS = O_DSTS + (size_t)SB * 8 * 128 * 128;
constexpr size_t O_FCONVS = O_DCONVS + (size_t)SB * 3 * 3072;
constexpr size_t O_END = O_FCONVS + (size_t)SB * 2 * FF;

constexpr size_t MiB = 1u << 20;
constexpr size_t WS_CTL = 0, CTL_ZERO_BYTES = 1 * MiB;
constexpr size_t WS_WIN = 1 * MiB;
constexpr size_t WS_WA = WS_WIN + (size_t)NIN * D * 2;
constexpr size_t WS_WB = WS_WA + (size_t)D * 256 * 2;
constexpr size_t WS_WOUT = WS_WB + (size_t)D * D * 2;
constexpr size_t WS_WMQ = WS_WOUT + (size_t)D * D * 2;
constexpr size_t WS_WMKV = WS_WMQ + (size_t)512 * D * 2;
constexpr size_t WS_WMO = WS_WMKV + (size_t)D * D * 2;
constexpr size_t WS_WUP = WS_WMO + (size_t)D * 512 * 2;
constexpr size_t WS_WDN = WS_WUP + (size_t)NUP * D * 2;
constexpr size_t WS_XN = WS_WDN + (size_t)D * FF * 2;
constexpr size_t WS_MN = WS_XN + (size_t)MT * D * 2;
constexpr size_t WS_MEMKV = WS_MN + (size_t)2048 * D * 2;
constexpr size_t WS_LSE = WS_MEMKV + (size_t)2048 * D * 2;
constexpr size_t WS_BIAS = WS_LSE + (size_t)3 * MP * 4 * 4;
constexpr size_t WS_OA = WS_BIAS + 8192;
constexpr size_t WS_R1 = WS_OA + (size_t)MT * 256 * 2;
constexpr size_t WS_R2 = WS_R1 + (size_t)MT * NPA * 2;
constexpr size_t WS_R3 = WS_R2 + (size_t)MT * NPB * 2;
constexpr size_t CH_STRIDE = 66560;
constexpr size_t WS_END = WS_R3 + (size_t)2048 * CH_STRIDE;
constexpr size_t WS_HB = WS_R3;
constexpr size_t WS_T1 = WS_HB + (size_t)MT * D * 2;
constexpr size_t WS_QM = WS_T1 + (size_t)MT * D * 2;
constexpr size_t WS_OM = WS_QM + (size_t)MT * 512 * 2;
constexpr size_t WS_ACT = WS_T1;
constexpr size_t WS_GU = WS_R1;
static_assert(WS_END <= 512 * MiB, "workspace map exceeds the guaranteed 512 MiB");
static_assert(WS_OM + (size_t)MT * 512 * 2 <= WS_END && WS_ACT + (size_t)MT * FF * 2 <= WS_END, "R3 overlay");
static_assert(WS_GU + (size_t)MT * NUP * 2 <= WS_R3, "GU spans R1+R2");
static_assert(WS_XN % 256 == 0 && WS_R1 % 256 == 0 && WS_R2 % 256 == 0 && WS_R3 % 256 == 0 && WS_OA % 256 == 0, "alignment");
constexpr int CW_Q0 = 64, CW_Q1 = 128, CW_Q2 = 192;
constexpr int CW_SK0 = 256;
constexpr int CW_BAR = 4096;
constexpr size_t CTL_SSQ1 = 64 * 1024, CTL_SSQ2 = 192 * 1024;

constexpr int RING_BYTES = 147456;
constexpr int LDSCTL_OFF = RING_BYTES, MISC_OFF = LDSCTL_OFF + 64;
constexpr int LDS_BYTES = RING_BYTES + 512;

#define LDS_WAIT() asm volatile("s_waitcnt lgkmcnt(0)" ::: "memory")
#define VM_WAIT() asm volatile("s_waitcnt vmcnt(0)" ::: "memory")
#define RLX_AGENT __ATOMIC_RELAXED, __HIP_MEMORY_SCOPE_AGENT

typedef float f32x2_ __attribute__((ext_vector_type(2)));
typedef __bf16 bf16x2_ __attribute__((ext_vector_type(2)));
__device__ __forceinline__ unsigned cvt_pk_bf16(float lo, float hi) { const f32x2_ v = {lo, hi}; const bf16x2_ b = __builtin_convertvector(v, bf16x2_); return __builtin_bit_cast(unsigned, b); }
__device__ __forceinline__ float bf_lo(unsigned w) { return __uint_as_float(w << 16); }
__device__ __forceinline__ float bf_hi(unsigned w) { return __uint_as_float(w & 0xffff0000u); }
__device__ __forceinline__ float bf2f(bf16_t h) { return __uint_as_float((unsigned)h << 16); }
__device__ __forceinline__ bf16_t f2bf(float f) { const __bf16 b = (__bf16)f; return __builtin_bit_cast(bf16_t, b); }
__device__ __forceinline__ u32x4 pack8(const f32x4 a, const f32x4 b) { u32x4 w; w.x = cvt_pk_bf16(a[0], a[1]); w.y = cvt_pk_bf16(a[2], a[3]); w.z = cvt_pk_bf16(b[0], b[1]); w.w = cvt_pk_bf16(b[2], b[3]); return w; }
__device__ __forceinline__ void unpack8(const u32x4 w, float (&f)[8]) { f[0] = bf_lo(w.x); f[1] = bf_hi(w.x); f[2] = bf_lo(w.y); f[3] = bf_hi(w.y); f[4] = bf_lo(w.z); f[5] = bf_hi(w.z); f[6] = bf_lo(w.w); f[7] = bf_hi(w.w); }
__device__ __forceinline__ float sigmoidf_(float x) { return __builtin_amdgcn_rcpf(1.f + __expf(-x)); }
__device__ __forceinline__ float siluf_(float x) { return x * __builtin_amdgcn_rcpf(1.f + __expf(-x)); }
__device__ __forceinline__ float wave_sum(float v) {
#pragma unroll
    for (int o = 1; o < 64; o <<= 1) v += __shfl_xor(v, o);
    return v;
}
__device__ __forceinline__ float wave_max(float v) {
#pragma unroll
    for (int o = 1; o < 64; o <<= 1) v = fmaxf(v, __shfl_xor(v, o));
    return v;
}

struct EpiProj {
    static constexpr bool PERM = true, AFTER_DRAIN = false;
    bf16_t* pa; bf16_t* pb;
    __device__ __forceinline__ void operator()(const f32x4 (&acc)[2][2][4][2], const pg8::Unit& u, int wr, int wc, int fr, int fq) const {
        const int colt = u.pn * 256; bf16_t* base; int ldc, c0;
        if (colt < NPA) { base = pa; ldc = NPA; c0 = colt; } else { base = pb; ldc = NPB; c0 = colt - NPA; }
        const int row0 = u.pm * 256 + wr * 64 + fr, col0 = c0 + wc * 32 + 8 * fq;
#pragma unroll
        for (int ai = 0; ai < 2; ++ai)
#pragma unroll
            for (int m = 0; m < 4; ++m) { bf16_t* rowp = base + (size_t)(row0 + ai * 128 + m * 16) * ldc + col0;
#pragma unroll
                for (int bj = 0; bj < 2; ++bj) *(u32x4*)(rowp + bj * 128) = pack8(acc[ai][bj][m][0], acc[ai][bj][m][1]); }
    }
    __device__ __forceinline__ void tail(int row, int col, f32x4 v, int) const {
        u32x2 w; w.x = cvt_pk_bf16(v[0], v[1]); w.y = cvt_pk_bf16(v[2], v[3]);
        if (col < NPA) *(u32x2*)(pa + (size_t)row * NPA + col) = w; else *(u32x2*)(pb + (size_t)row * NPB + (col - NPA)) = w;
    }
};
struct EpiMemKV {
    static constexpr bool PERM = true, AFTER_DRAIN = false;
    bf16_t* O; float* kout; float* vout;
    __device__ __forceinline__ void operator()(const f32x4 (&acc)[2][2][4][2], const pg8::Unit& u, int wr, int wc, int fr, int fq) const {
        asm volatile("" : "+v"(fr), "+v"(fq));
        const int row0 = u.pm * 256 + wr * 64 + fr, col0 = u.pn * 256 + wc * 32 + 8 * fq;
#pragma unroll
        for (int ai = 0; ai < 2; ++ai)
#pragma unroll
            for (int m = 0; m < 4; ++m) { const int row = row0 + ai * 128 + m * 16;
#pragma unroll
                for (int bj = 0; bj < 2; ++bj) { const int col = col0 + bj * 128; const f32x4 v0 = acc[ai][bj][m][0], v1 = acc[ai][bj][m][1];
                    *(u32x4*)(O + (size_t)row * 1024 + col) = pack8(v0, v1);
                    float* dst = col < 512 ? kout + (size_t)row * 512 + col : vout + (size_t)row * 512 + (col - 512);
                    *(f32x4*)dst = v0; *(f32x4*)(dst + 4) = v1; } }
    }
};
template <bool SECOND> struct EpiBranch {
    static constexpr bool PERM = true, AFTER_DRAIN = false;
    bf16_t* T1; const bf16_t* pb;
    __device__ __forceinline__ void operator()(const f32x4 (&acc)[2][2][4][2], const pg8::Unit& u, int wr, int wc, int fr, int fq) const {
        asm volatile("" : "+v"(fr), "+v"(fq));
        const int row0 = u.pm * 256 + wr * 64 + fr, col0 = u.pn * 256 + wc * 32 + 8 * fq;
#pragma unroll
        for (int ai = 0; ai < 2; ++ai)
#pragma unroll
            for (int m = 0; m < 4; ++m) { const int row = row0 + ai * 128 + m * 16;
#pragma unroll
                for (int bj = 0; bj < 2; ++bj) { const int col = col0 + bj * 128;
                    const u32x4 gw = *(const u32x4*)(pb + (size_t)row * NPB + (SECOND ? PB_GB : PB_GA) + col); float g[8]; unpack8(gw, g);
                    f32x4 v0 = acc[ai][bj][m][0], v1 = acc[ai][bj][m][1];
#pragma unroll
                    for (int e = 0; e < 4; ++e) { v0[e] *= sigmoidf_(g[e]); v1[e] *= sigmoidf_(g[4 + e]); }
                    bf16_t* tp = T1 + (size_t)row * D + col;
                    if (SECOND) { const u32x4 tw = *(const u32x4*)tp; float t[8]; unpack8(tw, t);
#pragma unroll
                        for (int e = 0; e < 4; ++e) { v0[e] += t[e]; v1[e] += t[4 + e]; } }
                    *(u32x4*)tp = pack8(v0, v1); }
                asm volatile("" ::: "memory"); }
    }
    __device__ __forceinline__ void tail(int row, int col, f32x4 v, int) const {
        const u32x2 gw = *(const u32x2*)(pb + (size_t)row * NPB + (SECOND ? PB_GB : PB_GA) + col);
        v[0] *= sigmoidf_(bf_lo(gw.x)); v[1] *= sigmoidf_(bf_hi(gw.x)); v[2] *= sigmoidf_(bf_lo(gw.y)); v[3] *= sigmoidf_(bf_hi(gw.y));
        bf16_t* tp = T1 + (size_t)row * D + col;
        if (SECOND) { const u32x2 tw = *(const u32x2*)tp; v[0] += bf_lo(tw.x); v[1] += bf_hi(tw.x); v[2] += bf_lo(tw.y); v[3] += bf_hi(tw.y); }
        u32x2 w; w.x = cvt_pk_bf16(v[0], v[1]); w.y = cvt_pk_bf16(v[2], v[3]); *(u32x2*)tp = w;
    }
};
template <bool FROM_X, bool WF32, bool WBF, bool SSQ> struct EpiResid {
    static constexpr bool PERM = true, AFTER_DRAIN = false;
    const float* xp; const float* xs; float* H; bf16_t* HB; float* ssq;
    __device__ __forceinline__ void operator()(const f32x4 (&acc)[2][2][4][2], const pg8::Unit& u, int wr, int wc, int fr, int fq) const {
        asm volatile("" : "+v"(fr), "+v"(fq));
        const int row0 = u.pm * 256 + wr * 64 + fr, col0 = u.pn * 256 + wc * 32 + 8 * fq;
#pragma unroll
        for (int ai = 0; ai < 2; ++ai)
#pragma unroll
            for (int m = 0; m < 4; ++m) { const int row = row0 + ai * 128 + m * 16; const bool valid = row < MV; float part = 0.f;
#pragma unroll
                for (int bj = 0; bj < 2; ++bj) { const int col = col0 + bj * 128;
                    f32x4 v0 = acc[ai][bj][m][0], v1 = acc[ai][bj][m][1];
                    if (valid) {
                        if (FROM_X) { const float* src = (row < MP ? xp + (size_t)row * D : xs + (size_t)(row - MP) * D) + col; v0 += *(const f32x4*)src; v1 += *(const f32x4*)(src + 4); }
                        else { const u32x4 bw = *(const u32x4*)(HB + (size_t)row * D + col); float bv[8]; unpack8(bw, bv);
#pragma unroll
                            for (int e = 0; e < 4; ++e) { v0[e] += bv[e]; v1[e] += bv[4 + e]; } }
                        if (WF32) { *(f32x4*)(H + (size_t)row * D + col) = v0; *(f32x4*)(H + (size_t)row * D + col + 4) = v1; }
                    } else { v0 = (f32x4){0.f, 0.f, 0.f, 0.f}; v1 = v0; }
                    if (WBF) *(u32x4*)(HB + (size_t)row * D + col) = pack8(v0, v1);
                    if (SSQ) part += (v0[0] * v0[0] + v0[1] * v0[1]) + (v0[2] * v0[2] + v0[3] * v0[3]) + (v1[0] * v1[0] + v1[1] * v1[1]) + (v1[2] * v1[2] + v1[3] * v1[3]); }
                if (SSQ) { part += __shfl_xor(part, 16); part += __shfl_xor(part, 32); if (fq == 0 && valid) atomicAdd(ssq + row, part); } }
    }
    __device__ __forceinline__ void tail(int row, int col, f32x4 v, int q) const {
        if (FROM_X) v += *(const f32x4*)(xs + (size_t)(row - MP) * D + col);
        else { const u32x2 bw = *(const u32x2*)(HB + (size_t)row * D + col); v[0] += bf_lo(bw.x); v[1] += bf_hi(bw.x); v[2] += bf_lo(bw.y); v[3] += bf_hi(bw.y); }
        if (WF32) *(f32x4*)(H + (size_t)row * D + col) = v;
        if (WBF) { u32x2 w; w.x = cvt_pk_bf16(v[0], v[1]); w.y = cvt_pk_bf16(v[2], v[3]); *(u32x2*)(HB + (size_t)row * D + col) = w; }
        if (SSQ) { float part = (v[0] * v[0] + v[1] * v[1]) + (v[2] * v[2] + v[3] * v[3]); part += __shfl_xor(part, 16); part += __shfl_xor(part, 32); if (q == 0) atomicAdd(ssq + row, part); }
    }
};
struct EpiScale {
    static constexpr bool PERM = true, AFTER_DRAIN = false;
    bf16_t* O; int ldc; const float* ssq;
    __device__ __forceinline__ void operator()(const f32x4 (&acc)[2][2][4][2], const pg8::Unit& u, int wr, int wc, int fr, int fq) const {
        asm volatile("" : "+v"(fr), "+v"(fq));
        const int row0 = u.pm * 256 + wr * 64 + fr, col0 = u.pn * 256 + wc * 32 + 8 * fq;
#pragma unroll
        for (int ai = 0; ai < 2; ++ai)
#pragma unroll
            for (int m = 0; m < 4; ++m) { const int row = row0 + ai * 128 + m * 16; const float rs = rsqrtf(ssq[row] * (1.f / D) + EPS);
#pragma unroll
                for (int bj = 0; bj < 2; ++bj) *(u32x4*)(O + (size_t)row * ldc + col0 + bj * 128) = pack8(acc[ai][bj][m][0] * rs, acc[ai][bj][m][1] * rs); }
    }
    __device__ __forceinline__ void tail(int row, int col, f32x4 v, int) const {
        const float rs = rsqrtf(ssq[row] * (1.f / D) + EPS); u32x2 w; w.x = cvt_pk_bf16(v[0] * rs, v[1] * rs); w.y = cvt_pk_bf16(v[2] * rs, v[3] * rs);
        *(u32x2*)(O + (size_t)row * ldc + col) = w;
    }
};
#define XB_TMO      128
#define XB_XCNT(j)  (256  + 64 * (j))
#define XB_XSUB(j)  (1280 + 64 * (j))
#define XB_XGEN(j)  (2304 + 64 * (j))
#define XB_TOP      3328
#define XB_TOPGEN   3392
#define XCD_BAR_WORDS 3456
#define XB_SPIN_CAP (1u << 22)

__device__ __forceinline__ unsigned xb_ld(unsigned* p)              { return __hip_atomic_load(p, __ATOMIC_RELAXED, __HIP_MEMORY_SCOPE_AGENT); }
__device__ __forceinline__ unsigned xb_add(unsigned* p, unsigned v) { return __hip_atomic_fetch_add(p, v, __ATOMIC_RELAXED, __HIP_MEMORY_SCOPE_AGENT); }
__device__ __forceinline__ unsigned xb_xcc_id() { return (unsigned)__builtin_amdgcn_s_getreg((3 << 11) | 20) & 0xFu; }
#define XB_SPIN(cond, bar) do { unsigned _sp = 0; while (cond) { __builtin_amdgcn_s_sleep(1); \
    if ((++_sp & 255u) == 0u) { if (xb_ld(&(bar)[XB_TMO])) break; if (_sp > XB_SPIN_CAP) { atomicAdd(&(bar)[XB_TMO], 1u); break; } } } } while (0)

struct XcdBarrier {
    unsigned* bar; unsigned x;
    volatile LAS unsigned* st;
};

__device__ __forceinline__ XcdBarrier xcd_barrier_post(unsigned* bar, volatile LAS unsigned* st) {
    XcdBarrier b; b.bar = bar; b.x = xb_xcc_id(); b.st = st;
    if (threadIdx.x == 0) (void)xb_add(&bar[XB_XCNT(b.x)], 1u);
    return b;
}
__device__ __forceinline__ void xcd_barrier_complete(unsigned* bar, unsigned x, unsigned& nloc, unsigned& nx) {
    const unsigned G = gridDim.x * gridDim.y * gridDim.z;
    unsigned sum, cnt, mine, sp = 0u;
    for (;;) {
        sum = 0u; cnt = 0u; mine = 0u;
#pragma unroll
        for (unsigned j = 0; j < 16; ++j) { const unsigned c = xb_ld(&bar[XB_XCNT(j)]); sum += c; cnt += (c > 0u) ? 1u : 0u; mine = (j == x) ? c : mine; }
        if (sum == G) break;
        __builtin_amdgcn_s_sleep(1);
        if ((++sp & 255u) == 0u) { if (xb_ld(&bar[XB_TMO])) break; if (sp > XB_SPIN_CAP) { atomicAdd(&bar[XB_TMO], 1u); break; } }
    }
    nloc = mine > 0u ? mine : 1u; nx = cnt > 0u ? cnt : 1u;
}

__device__ __forceinline__ void xcd_barrier(const XcdBarrier& b) {
    asm volatile("s_waitcnt vmcnt(0)" ::: "memory");
    __syncthreads();
    if (threadIdx.x == 0) {
        unsigned* bar = b.bar;
        __builtin_amdgcn_s_waitcnt(0);
        unsigned nloc = b.st[0], nx = b.st[1];
        if (nloc == 0u) { xcd_barrier_complete(bar, b.x, nloc, nx); b.st[0] = nloc; b.st[1] = nx; }
        const unsigned old = xb_add(&bar[XB_XSUB(b.x)], 1u);
        const unsigned gen = old / nloc;
        if (old + 1u == (gen + 1u) * nloc) {
            __builtin_amdgcn_fence(__ATOMIC_RELEASE, "agent");
            asm volatile("s_waitcnt vmcnt(0)" ::: "memory");
            const unsigned og = xb_add(&bar[XB_TOP], 1u);
            const unsigned tg = og / nx;
            if (og + 1u == (tg + 1u) * nx) xb_add(&bar[XB_TOPGEN], 1u);
            else XB_SPIN(xb_ld(&bar[XB_TOPGEN]) == tg, bar);
            __builtin_amdgcn_fence(__ATOMIC_ACQUIRE, "agent");
            xb_add(&bar[XB_XGEN(b.x)], 1u);
            asm volatile("s_waitcnt vmcnt(0)" ::: "memory");
        } else {
            XB_SPIN(xb_ld(&bar[XB_XGEN(b.x)]) == gen, bar);
            __builtin_amdgcn_fence(__ATOMIC_ACQUIRE, "agent");
            asm volatile("s_waitcnt vmcnt(0)" ::: "memory");
        }
    }
    __syncthreads();
}

struct Ctx {
    LAS unsigned char* lds; volatile LAS unsigned* MISC;
    int tid, lane, wave, G, gw, NGW, gtid, NGT;
    float* out; unsigned char* ws; unsigned* ctl;
};
struct Args { const float* in[32]; float* out; unsigned char* ws; int ph_lo, ph_hi, li, pad; };
typedef const __attribute__((address_space(4))) Args CArgs;
#define MK_IN(i) (A->in[i])
template <class T> __device__ __forceinline__ T* wsp(const Ctx& C, size_t off) { return (T*)(C.ws + off); }

__device__ __forceinline__ int next_unit(const Ctx& C, int cw) {
    __syncthreads();
    if (C.tid == 0) C.MISC[4] = __hip_atomic_fetch_add(C.ctl + cw, 1u, RLX_AGENT);
    __syncthreads();
    return (int)C.MISC[4];
}

template <bool STATIC, int K, class Epi>
__device__ __forceinline__ void skinny_phase(const Ctx& C, int cw, const bf16_t* A, const bf16_t* Bt, int N, const Epi& E) {
    constexpr int KW = K / 8, NS = KW / 32; static_assert(KW % 32 == 0, "skinny K split");
    const int lr = C.lane & 15, q = C.lane >> 4, w = C.wave;
    const bf16_t* ab = A + (size_t)(MP + lr) * K + w * KW + 8 * q;
    LAS f32x4* part = (LAS f32x4*)C.lds;
    const int nu = N >> 4;
    for (int us = blockIdx.x;; us += gridDim.x) { const int u = STATIC ? us : next_unit(C, cw); if (u >= nu) break;
        const bf16_t* bb = Bt + (size_t)(16 * u + lr) * K + w * KW + 8 * q;
        f32x4 acc[8]; const bf16_t* abm[8];
#pragma unroll
        for (int mt = 0; mt < 8; ++mt) { acc[mt] = (f32x4){0.f, 0.f, 0.f, 0.f}; abm[mt] = ab + (size_t)mt * 16 * K; asm volatile("" : "+v"(abm[mt])); }
        asm volatile("" : "+v"(bb));
#pragma unroll
        for (int s0_ = 0; s0_ < NS; s0_ += 4) {
            bf16x8 bf[4], af[4][8];
#pragma unroll
            for (int s = 0; s < 4; ++s) if (s0_ + s < NS) { bf[s] = *(const bf16x8*)(bb + 32 * (s0_ + s));
#pragma unroll
                for (int mt = 0; mt < 8; ++mt) af[s][mt] = *(const bf16x8*)(abm[mt] + 32 * (s0_ + s)); }
            __builtin_amdgcn_sched_barrier(0);
#pragma unroll
            for (int s = 0; s < 4; ++s) if (s0_ + s < NS) {
#pragma unroll
                for (int mt = 0; mt < 8; ++mt) acc[mt] = __builtin_amdgcn_mfma_f32_16x16x32_bf16(bf[s], af[s][mt], acc[mt], 0, 0, 0); }
            __builtin_amdgcn_sched_barrier(0);
        }
        if (STATIC) __syncthreads();
#pragma unroll
        for (int mt = 0; mt < 8; ++mt) part[(w * 8 + mt) * 64 + C.lane] = acc[mt];
        __syncthreads();
        f32x4 sum = part[w * 64 + C.lane];
#pragma unroll
        for (int sw = 1; sw < 8; ++sw) sum += part[(sw * 8 + w) * 64 + C.lane];
        E.tail(MP + 16 * w + lr, 16 * u + 4 * q, sum, q);
    }
    __syncthreads();
}
__device__ __forceinline__ void tr_item(const float* W, int ldw, int k0, int nsrc0, int nvalid, bf16_t* WT, int ldt, int ndst0, const float* gain, LAS float* scr, int lane) {
    const int n_ = lane & 31;
#pragma unroll 8
    for (int i = 0; i < 32; ++i) { const int kk = 2 * i + (lane >> 5); float v = (n_ < nvalid) ? W[(size_t)(k0 + kk) * ldw + nsrc0 + n_] : 0.f; if (gain) v *= gain[k0 + kk]; scr[kk * 33 + n_] = v; }
    LDS_WAIT(); asm volatile("" ::: "memory");
    const int c = lane & 7;
#pragma unroll
    for (int j = 0; j < 4; ++j) { const int n = (lane >> 3) + 8 * j; const LAS float* s = scr + (8 * c) * 33 + n;
        u32x4 o; o.x = cvt_pk_bf16(s[0 * 33], s[1 * 33]); o.y = cvt_pk_bf16(s[2 * 33], s[3 * 33]); o.z = cvt_pk_bf16(s[4 * 33], s[5 * 33]); o.w = cvt_pk_bf16(s[6 * 33], s[7 * 33]);
        *(u32x4*)(WT + (size_t)(ndst0 + n) * ldt + k0 + 8 * c) = o; }
    LDS_WAIT(); asm volatile("" ::: "memory");
}
__device__ __forceinline__ void rms_row_bf16(const float* xrow, const float* gain, bf16_t* orow, int lane) {
    const f32x4* xr = (const f32x4*)xrow + lane; const f32x4* gr = (const f32x4*)gain + lane;
    f32x4 v[4]; float s = 0.f;
#pragma unroll
    for (int j = 0; j < 4; ++j) { v[j] = xr[64 * j]; s += (v[j].x * v[j].x + v[j].y * v[j].y) + (v[j].z * v[j].z + v[j].w * v[j].w); }
    const float rs = rsqrtf(wave_sum(s) * (1.f / D) + EPS);
    u32x2* o8 = (u32x2*)orow + lane;
#pragma unroll
    for (int j = 0; j < 4; ++j) { const f32x4 g = gr[64 * j]; u32x2 w; w.x = cvt_pk_bf16(v[j].x * rs * g.x, v[j].y * rs * g.y); w.y = cvt_pk_bf16(v[j].z * rs * g.z, v[j].w * rs * g.w); o8[64 * j] = w; }
}
__device__ __forceinline__ int rel_bucket(int dist) {
    if (dist < 16) return dist;
    const float dd = (float)dist;
    int large = 16 + (int)(logf(dd / 16.f) / logf(128.f) * 16.f);
    return large < 31 ? large : 31;
}
constexpr int CC_N0 = SB * 124 * 128, CC_N1 = SB * 508 * 128, CC_N2 = SB * 2044 * 128, CC_TOTAL = CC_N0 + CC_N1 + CC_N2;
__device__ __forceinline__ f32x4 cache_copy_load(CArgs* A, int i) {
    int L, n4; const f32x4* src;
    if (i < CC_N0) { L = 128; n4 = 124 * 128; src = (const f32x4*)MK_IN(2); }
    else if (i < CC_N0 + CC_N1) { i -= CC_N0; L = 512; n4 = 508 * 128; src = (const f32x4*)MK_IN(3); }
    else { i -= CC_N0 + CC_N1; L = 2048; n4 = 2044 * 128; src = (const f32x4*)MK_IN(4); }
    const int bb = i / n4, r = i - bb * n4;
    return __builtin_nontemporal_load(src + (size_t)bb * L * 128 + 512 + r);
}
__device__ __forceinline__ void cache_copy_store(float* out, int i, f32x4 v) {
    int L, n4; f32x4* dst;
    if (i < CC_N0) { L = 128; n4 = 124 * 128; dst = (f32x4*)(out + O_DIL0S); }
    else if (i < CC_N0 + CC_N1) { i -= CC_N0; L = 512; n4 = 508 * 128; dst = (f32x4*)(out + O_DIL1S); }
    else { i -= CC_N0 + CC_N1; L = 2048; n4 = 2044 * 128; dst = (f32x4*)(out + O_DIL2S); }
    const int bb = i / n4, r = i - bb * n4;
    __builtin_nontemporal_store(v, dst + (size_t)bb * L * 128 + r);
}
__device__ __forceinline__ void cache_copy_item(CArgs* A, float* out, int i) {
    int L, n4; const f32x4* src; f32x4* dst;
    if (i < CC_N0) { L = 128; n4 = 124 * 128; src = (const f32x4*)MK_IN(2); dst = (f32x4*)(out + O_DIL0S); }
    else if (i < CC_N0 + CC_N1) { i -= CC_N0; L = 512; n4 = 508 * 128; src = (const f32x4*)MK_IN(3); dst = (f32x4*)(out + O_DIL1S); }
    else { i -= CC_N0 + CC_N1; L = 2048; n4 = 2044 * 128; src = (const f32x4*)MK_IN(4); dst = (f32x4*)(out + O_DIL2S); }
    const int bb = i / n4, r = i - bb * n4;
    dst[(size_t)bb * L * 128 + r] = __builtin_nontemporal_load(src + (size_t)bb * L * 128 + 512 + r);
}
constexpr int CC_SCAN = 256 * 32 * 384, CC_CHUNK = 8192, CC_NCHUNK = (CC_TOTAL - CC_SCAN + CC_CHUNK - 1) / CC_CHUNK;
__device__ __forceinline__ void copy_window(CArgs* A, const Ctx& C, int cw, int c0, int c1) {
    for (;;) { const int c = c0 + next_unit(C, cw); if (c >= c1) break;
        const int base = CC_SCAN + c * CC_CHUNK + C.tid;
        f32x4 v[16];
#pragma unroll
        for (int j = 0; j < 16; ++j) { const int it = base + 512 * j; if (it < CC_TOTAL) v[j] = cache_copy_load(A, it); }
        __builtin_amdgcn_sched_barrier(0);
#pragma unroll
        for (int j = 0; j < 16; ++j) { const int it = base + 512 * j; if (it < CC_TOTAL) cache_copy_store(C.out, it, v[j]); }
    }
}
__device__ __forceinline__ void p0_prologue(CArgs* A, const Ctx& C) {
    LAS float* scr = (LAS float*)(C.lds + C.wave * 16384);
    bf16_t* Win = wsp<bf16_t>(C, WS_WIN);
    constexpr int I1 = 16 * 200, I2 = 16 * 32, I3 = 16 * 32, I4 = 16, I5 = 4 * 32, I6 = 16 * 32, I7 = 16 * 32, I8 = 16 * 16, I9 = 16 * 32, I10 = 8 * 32, I11 = 16 * 176, I12 = 44 * 32;
    constexpr int NITEMS = I1 + I2 + I3 + I4 + I5 + I6 + I7 + I8 + I9 + I10 + I11 + I12;
    for (int it = C.gw; it < NITEMS; it += C.NGW) {
        int r = it;
        if (r < I1) { tr_item(MK_IN(13), 8464, 64 * (r / 200), 32 * (r % 200), 32, Win, D, 32 * (r % 200), nullptr, scr, C.lane); continue; } r -= I1;
        if (r < I2) { tr_item(MK_IN(13), 8464, 64 * (r / 32), 6416 + 32 * (r % 32), 32, Win, D, 6400 + 32 * (r % 32), nullptr, scr, C.lane); continue; } r -= I2;
        if (r < I3) { tr_item(MK_IN(13), 8464, 64 * (r / 32), 7440 + 32 * (r % 32), 32, Win, D, 7424 + 32 * (r % 32), nullptr, scr, C.lane); continue; } r -= I3;
        if (r < I4) { tr_item(MK_IN(13), 8464, 64 * r, 6400, 16, Win, D, 8448, nullptr, scr, C.lane); continue; } r -= I4;
        if (r < I5) { tr_item(MK_IN(18), 1024, 64 * (r / 32), 32 * (r % 32), 32, wsp<bf16_t>(C, WS_WA), 256, 32 * (r % 32), nullptr, scr, C.lane); continue; } r -= I5;
        if (r < I6) { tr_item(MK_IN(19), 1024, 64 * (r / 32), 32 * (r % 32), 32, wsp<bf16_t>(C, WS_WB), D, 32 * (r % 32), nullptr, scr, C.lane); continue; } r -= I6;
        if (r < I7) { tr_item(MK_IN(20), 1024, 64 * (r / 32), 32 * (r % 32), 32, wsp<bf16_t>(C, WS_WOUT), D, 32 * (r % 32), nullptr, scr, C.lane); continue; } r -= I7;
        if (r < I8) { tr_item(MK_IN(23), 512, 64 * (r / 16), 32 * (r % 16), 32, wsp<bf16_t>(C, WS_WMQ), D, 32 * (r % 16), MK_IN(21), scr, C.lane); continue; } r -= I8;
        if (r < I9) { tr_item(MK_IN(24), 1024, 64 * (r / 32), 32 * (r % 32), 32, wsp<bf16_t>(C, WS_WMKV), D, 32 * (r % 32), nullptr, scr, C.lane); continue; } r -= I9;
        if (r < I10) { tr_item(MK_IN(25), 1024, 64 * (r / 32), 32 * (r % 32), 32, wsp<bf16_t>(C, WS_WMO), 512, 32 * (r % 32), nullptr, scr, C.lane); continue; } r -= I10;
        if (r < I11) { tr_item(MK_IN(27), NUP, 64 * (r / 176), 32 * (r % 176), 32, wsp<bf16_t>(C, WS_WUP), D, 32 * (r % 176), MK_IN(26), scr, C.lane); continue; } r -= I11;
        tr_item(MK_IN(30), 1024, 64 * (r / 32), 32 * (r % 32), 32, wsp<bf16_t>(C, WS_WDN), FF, 32 * (r % 32), nullptr, scr, C.lane);
    }
    { u32x4* z = (u32x4*)(Win + (size_t)8480 * D); const int n16 = (NIN - 8480) * D * 2 / 16; for (int i = C.gtid; i < n16; i += C.NGT) z[i] = (u32x4){0u, 0u, 0u, 0u}; }
    bf16_t* XN = wsp<bf16_t>(C, WS_XN); bf16_t* MN = wsp<bf16_t>(C, WS_MN);
    for (int m = C.gw; m < MV; m += C.NGW) rms_row_bf16(m < MP ? MK_IN(0) + (size_t)m * D : MK_IN(1) + (size_t)(m - MP) * D, MK_IN(12), XN + (size_t)m * D, C.lane);
    { u32x4* z = (u32x4*)(XN + (size_t)MV * D); const int n16 = (MT - MV) * D * 2 / 16; for (int i = C.gtid; i < n16; i += C.NGT) z[i] = (u32x4){0u, 0u, 0u, 0u}; }
    for (int m = C.gw; m < 2048; m += C.NGW) rms_row_bf16(MK_IN(10) + (size_t)m * D, MK_IN(22), MN + (size_t)m * D, C.lane);
    { float* bt = wsp<float>(C, WS_BIAS); const float* rb = MK_IN(11);
      for (int i = C.gtid; i < 12 * 129; i += C.NGT) { const int gh = i / 129, j = i % 129, g = gh >> 2, dil = (g == 0) ? 1 : (g == 1 ? 4 : 16); bt[gh * 132 + j] = rb[rel_bucket(dil * j) * 12 + gh]; } }
    if (!MK_SCAN_COPY) for (int i = C.gtid; i < CC_TOTAL; i += C.NGT) cache_copy_item(A, C.out, i);
}

__device__ __forceinline__ void cp8(const bf16_t* src, float* dst) {
    const u32x4 w = *(const u32x4*)src; float f[8]; unpack8(w, f);
    *(f32x4*)dst = (f32x4){f[0], f[1], f[2], f[3]}; *(f32x4*)(dst + 4) = (f32x4){f[4], f[5], f[6], f[7]};
}
__device__ __forceinline__ void p2_state_copies(CArgs* A, const Ctx& C) {
    const bf16_t* PA = wsp<bf16_t>(C, WS_R1);
#pragma unroll
    for (int g = 0; g < 3; ++g) {
        const int W = (g == 0) ? 128 : (g == 1 ? 512 : 2048);
        float* dp = C.out + (g == 0 ? O_DIL0P : (g == 1 ? O_DIL1P : O_DIL2P));
        const int per_b = W * 64, tot = NB * per_b;
        for (int i = C.gtid; i < tot; i += C.NGT) { const int b = i / per_b, rem = i - b * per_b, rr = rem >> 6, c = (rem & 63) * 8;
            const int col = ((c >> 8) ? PA_VA : PA_KA) + g * 256 + (c & 255);
            cp8(PA + (size_t)(b * SEQ + SEQ - W + rr) * NPA + col, dp + (size_t)i * 8); }
        float* ds = C.out + (g == 0 ? O_DIL0S : (g == 1 ? O_DIL1S : O_DIL2S));
        for (int i = C.gtid; i < SB * ST * 64; i += C.NGT) { const int bt = i >> 6, c = (i & 63) * 8, b = bt >> 2, t = bt & 3;
            const int col = ((c >> 8) ? PA_VA : PA_KA) + g * 256 + (c & 255);
            cp8(PA + (size_t)(MP + bt) * NPA + col, ds + ((size_t)(b * W + W - 4 + t) * 512 + c)); }
    }
    for (int i = C.gtid; i < NB * 3 * 384; i += C.NGT) { const int bi = i / 384, c = (i % 384) * 8, b = bi / 3, ii = bi % 3;
        cp8(PA + (size_t)(b * SEQ + SEQ - 3 + ii) * NPA + PA_QB + c, C.out + O_DCONVP + (size_t)bi * 3072 + c); }
    for (int i = C.gtid; i < SB * 3 * 384; i += C.NGT) { const int bi = i / 384, c = (i % 384) * 8, b = bi / 3, ii = bi % 3;
        cp8(PA + (size_t)(MP + b * 4 + 1 + ii) * NPA + PA_QB + c, C.out + O_DCONVS + (size_t)bi * 3072 + c); }
}

typedef _Float16 f16x8 __attribute__((ext_vector_type(8)));
constexpr int PR_K = 0, PR_Q = 17408, PR_M = 34816, PR_G = PR_M + 8 * 8192, PR_B = PR_G + 2048, PR_END = PR_B + 2048;
static_assert(PR_END <= RING_BYTES, "prep LDS");
template <int I> struct SolveRow {
    static __device__ __forceinline__ void run(float (&t)[64], const LAS unsigned char* Mr, int lane) {
        SolveRow<I - 1>::run(t, Mr, lane);
        float a0 = (lane == I) ? 1.f : 0.f, a1 = 0.f;
#pragma unroll
        for (int j8 = 0; j8 < (I + 7) / 8; ++j8) { const f16x8 hv = *(const LAS f16x8*)(Mr + I * 128 + j8 * 16);
#pragma unroll
            for (int e = 0; e < 8; ++e) { const int jj = j8 * 8 + e; if (jj < I) { if (e & 1) a1 -= (float)hv[e] * t[jj]; else a0 -= (float)hv[e] * t[jj]; } } }
        t[I] = a0 + a1;
    }
};
template <> struct SolveRow<-1> { static __device__ __forceinline__ void run(float (&)[64], const LAS unsigned char*, int) {} };
__device__ __forceinline__ void gdn_prep_unit(CArgs* A, const Ctx& C, int unit) {
    const int b = unit >> 5, h = (unit >> 2) & 7, j = unit & 3;
    const bf16_t* PA = wsp<bf16_t>(C, WS_R1); const bf16_t* PB = wsp<bf16_t>(C, WS_R2);
    unsigned char* CH = wsp<unsigned char>(C, WS_R3);
    const int tid = C.tid, lane = C.lane, wave = C.wave, lr = lane & 15, q = lane >> 4;
    const int cg = tid % 48, tensor = cg >> 4, chg = cg & 15, rg = tid / 48;
    const int cidx = tensor * 1024 + h * 128 + 8 * chg;
    float w[4][8];
    if (tid < 384) {
#pragma unroll
        for (int jj = 0; jj < 4; ++jj) { const f32x4 a = *(const f32x4*)(MK_IN(14) + jj * 3072 + cidx), bq = *(const f32x4*)(MK_IN(14) + jj * 3072 + cidx + 4);
            w[jj][0] = a[0]; w[jj][1] = a[1]; w[jj][2] = a[2]; w[jj][3] = a[3]; w[jj][4] = bq[0]; w[jj][5] = bq[1]; w[jj][6] = bq[2]; w[jj][7] = bq[3]; }
    }
    __syncthreads();
    for (int ci = 0; ci < 8; ++ci) {
        const int n = 8 * j + ci, chunk = (b * 8 + h) * 32 + n, t0 = 64 * n;
        unsigned char* rec = CH + (size_t)chunk * CH_STRIDE;
        if (tid < 384) {
            float x[11][8];
#pragma unroll
            for (int i = 0; i < 11; ++i) { const int t = t0 + 8 * rg - 3 + i;
                if (t >= 0) { const u32x4 wv = *(const u32x4*)(PA + (size_t)(b * SEQ + t) * NPA + PA_QB + cidx); unpack8(wv, x[i]); }
                else {
#pragma unroll
                    for (int e = 0; e < 8; ++e) x[i][e] = 0.f; } }
#pragma unroll
            for (int r = 0; r < 8; ++r) { float y[8]; float ss = 0.f;
#pragma unroll
                for (int e = 0; e < 8; ++e) { float a = w[0][e] * x[r][e]; a += w[1][e] * x[r + 1][e]; a += w[2][e] * x[r + 2][e]; a += w[3][e] * x[r + 3][e]; a = siluf_(a); y[e] = a; ss += a * a; }
                ss += __shfl_xor(ss, 1); ss += __shfl_xor(ss, 2); ss += __shfl_xor(ss, 4); ss += __shfl_xor(ss, 8);
                const float sc = (tensor == 0) ? rsqrtf(ss + EPS) * 0.08838834764831845f : (tensor == 1 ? rsqrtf(ss + EPS) : 1.f);
                u32x4 o; o.x = cvt_pk_bf16(y[0] * sc, y[1] * sc); o.y = cvt_pk_bf16(y[2] * sc, y[3] * sc); o.z = cvt_pk_bf16(y[4] * sc, y[5] * sc); o.w = cvt_pk_bf16(y[6] * sc, y[7] * sc);
                const int row = 8 * rg + r;
                *(u32x4*)(rec + (tensor == 0 ? 16384 : (tensor == 1 ? 0 : 32768)) + row * 256 + chg * 16) = o;
                if (tensor < 2) *(LAS u32x4*)(C.lds + (tensor == 0 ? PR_Q : PR_K) + row * 272 + chg * 16) = o; }
        } else if (wave == 6) {
            const size_t row = (size_t)(b * SEQ + t0 + lane);
            const float braw = bf2f(PB[row * NPB + PB_BETA + h]), araw = bf2f(PB[row * NPB + PB_A + h]);
            const float beta = sigmoidf_(braw); const float xx = araw + MK_IN(16)[h];
            const float sp = fmaxf(xx, 0.f) + log1pf(__expf(-fabsf(xx)));
            float Gc = -__expf(MK_IN(15)[h]) * sp;
#pragma unroll
            for (int o = 1; o < 64; o <<= 1) { const float up = __shfl_up(Gc, o); if (lane >= o) Gc += up; }
            const float Gl = __shfl(Gc, 63);
            ((LAS float*)(C.lds + PR_G))[ci * 64 + lane] = Gc; ((LAS float*)(C.lds + PR_B))[ci * 64 + lane] = beta;
            float* gv = (float*)(rec + 65536); gv[lane] = __expf(Gc); gv[64 + lane] = __expf(Gl - Gc); if (lane == 0) gv[128] = __expf(Gl);
        }
        __syncthreads();
        {
            const int mi = wave >> 1, nh = wave & 1;
            const LAS float* Gs = (const LAS float*)(C.lds + PR_G) + ci * 64; const LAS float* Bs = (const LAS float*)(C.lds + PR_B) + ci * 64;
#pragma unroll
            for (int t2 = 0; t2 < 2; ++t2) { const int ni = 2 * nh + t2;
                f32x4 kk = {0.f, 0.f, 0.f, 0.f}, qk = {0.f, 0.f, 0.f, 0.f};
                if (ni <= mi) {
#pragma unroll
                    for (int s = 0; s < 4; ++s) {
                        const bf16x8 ak = *(const LAS bf16x8*)(C.lds + PR_K + (16 * mi + lr) * 272 + (32 * s + 8 * q) * 2);
                        const bf16x8 aq = *(const LAS bf16x8*)(C.lds + PR_Q + (16 * mi + lr) * 272 + (32 * s + 8 * q) * 2);
                        const bf16x8 bk = *(const LAS bf16x8*)(C.lds + PR_K + (16 * ni + lr) * 272 + (32 * s + 8 * q) * 2);
                        kk = __builtin_amdgcn_mfma_f32_16x16x32_bf16(ak, bk, kk, 0, 0, 0);
                        qk = __builtin_amdgcn_mfma_f32_16x16x32_bf16(aq, bk, qk, 0, 0, 0); }
                }
                const int e = 16 * ni + lr; const float Ge = Gs[e];
#pragma unroll
                for (int r = 0; r < 4; ++r) { const int c = 16 * mi + 4 * q + r; const float gam = (c >= e) ? __expf(Gs[c] - Ge) : 0.f;
                    const float mval = (c > e) ? Bs[c] * kk[r] * gam : 0.f; const float aval = qk[r] * gam;
                    *(LAS _Float16*)(C.lds + PR_M + ci * 8192 + (c * 64 + e) * 2) = (_Float16)mval;
                    *(bf16_t*)(rec + 57344 + (c * 64 + e) * 2) = f2bf(aval); }
            }
        }
        __syncthreads();
    }
    {
        const int ci = wave, chunk = (b * 8 + h) * 32 + 8 * j + ci;
        unsigned char* rec = CH + (size_t)chunk * CH_STRIDE;
        const LAS unsigned char* Mr = C.lds + PR_M + ci * 8192;
        float t[64];
        SolveRow<63>::run(t, Mr, lane);
        const float bc = ((const LAS float*)(C.lds + PR_B))[ci * 64 + lane];
        bf16_t* tp = (bf16_t*)(rec + 49152);
#pragma unroll
        for (int i = 0; i < 64; ++i) tp[i * 64 + lane] = f2bf(t[i] * bc);
    }
}

constexpr int SC_KN = 0, SC_QN = 17408, SC_V = 34816, SC_TP = 52224, SC_AI = 61440, SC_EG = 70656, SC_BUF = 71680;
static_assert(2 * SC_BUF <= RING_BYTES, "scan LDS");
__device__ __forceinline__ bf16x8 packB(const f32x4 a, const f32x4 b) { const u32x4 w = pack8(a, b); return __builtin_bit_cast(bf16x8, w); }
__device__ __forceinline__ bf16x8 ld_perm(const LAS unsigned char* base, int row, int stride, int k0, int q) {
    const u32x2 lo = *(const LAS u32x2*)(base + row * stride + (k0 + 4 * q) * 2), hi = *(const LAS u32x2*)(base + row * stride + (k0 + 16 + 4 * q) * 2);
    const u32x4 w = {lo.x, lo.y, hi.x, hi.y}; return __builtin_bit_cast(bf16x8, w);
}
typedef short s16x4 __attribute__((ext_vector_type(4)));
__device__ __forceinline__ bf16x8 ld_perm_tr(const LAS unsigned char* base, int c0, int k0, int lr, int q) {
    const LAS unsigned char* p = base + (k0 + 4 * q + (lr >> 2)) * 272 + (c0 + 4 * (lr & 3)) * 2;
    const s16x4 lo = __builtin_amdgcn_ds_read_tr16_b64_v4i16((LAS s16x4*)p), hi = __builtin_amdgcn_ds_read_tr16_b64_v4i16((LAS s16x4*)(p + 16 * 272));
    return __builtin_shufflevector(lo, hi, 0, 1, 2, 3, 4, 5, 6, 7);
}
#define SC_BARRIER() do { asm volatile("s_waitcnt lgkmcnt(0)" ::: "memory"); __builtin_amdgcn_s_barrier(); asm volatile("" ::: "memory"); } while (0)
__device__ __forceinline__ void gdn_scan_unit(CArgs* A, const Ctx& C, int bh, int quarter, int cc_slot) {
    const int tid = C.tid, lane = C.lane, wave = C.wave, lr = lane & 15, q = lane >> 4;
    const int b = bh >> 3, h = bh & 7;
    const unsigned char* CH = wsp<unsigned char>(C, WS_R3) + (size_t)bh * 32 * CH_STRIDE;
    __syncthreads();
    if (wave >= 2) {
        const int st = tid - 128;
        int loff[11];
#pragma unroll
        for (int i = 0; i < 11; ++i) { const int p = st + 384 * i; int off;
            if (p < 3072) off = (p >> 10) * 17408 + ((p & 1023) >> 4) * 272 + (p & 15) * 16;
            else { const int pp = p - 3072; off = SC_TP + (pp >> 9) * 9216 + ((pp & 511) >> 3) * 144 + (pp & 7) * 16; }
            loff[i] = off; }
        u32x4 pf[11]; float pfg = 0.f; f32x4 cc[1];
#define SC_LOAD(n_) do { const unsigned char* base_ = CH + (size_t)(n_) * CH_STRIDE; _Pragma("unroll") for (int i_ = 0; i_ < 11; ++i_) if (st + 384 * i_ < 4096) pf[i_] = *(const u32x4*)(base_ + (size_t)(st + 384 * i_) * 16); \
        if (st < 129) pfg = *(const float*)(base_ + 65536 + st * 4); } while (0)
#define SC_WRITE(buf_) do { LAS unsigned char* lb_ = C.lds + (buf_) * SC_BUF; _Pragma("unroll") for (int i_ = 0; i_ < 11; ++i_) if (st + 384 * i_ < 4096) *(LAS u32x4*)(lb_ + loff[i_]) = pf[i_]; \
        if (st < 129) ((LAS float*)(lb_ + SC_EG))[st] = pfg; } while (0)
        SC_LOAD(0); SC_WRITE(0); SC_LOAD(1);
        SC_BARRIER();
        for (int n = 0; n < 32; ++n) {
            if (n + 1 < 32) SC_WRITE((n + 1) & 1);
            if (n > 0) {
#pragma unroll
                for (int jc = 0; jc < 1; ++jc) { const int it = ((cc_slot * 32 + n - 1) * 384 + st) + jc * (256 * 32 * 384); if (MK_SCAN_COPY && it < CC_TOTAL) cache_copy_store(C.out, it, cc[jc]); } }
            if (n + 2 < 32) SC_LOAD(n + 2);
#pragma unroll
            for (int jc = 0; jc < 1; ++jc) { const int it = ((cc_slot * 32 + n) * 384 + st) + jc * (256 * 32 * 384); if (MK_SCAN_COPY && it < CC_TOTAL) cc[jc] = cache_copy_load(A, it); }
            SC_BARRIER();
        }
#pragma unroll
        for (int jc = 0; jc < 1; ++jc) { const int it = ((cc_slot * 32 + 31) * 384 + st) + jc * (256 * 32 * 384); if (MK_SCAN_COPY && it < CC_TOTAL) cache_copy_store(C.out, it, cc[jc]); }
#undef SC_LOAD
#undef SC_WRITE
        return;
    }
    bf16_t* PA = wsp<bf16_t>(C, WS_R1);
    const int cb = 32 * quarter + 16 * wave;
    f32x4 S[8];
#pragma unroll
    for (int i = 0; i < 8; ++i) S[i] = (f32x4){0.f, 0.f, 0.f, 0.f};
    SC_BARRIER();
    for (int n = 0; n < 32; ++n) {
        const LAS unsigned char* L = C.lds + (n & 1) * SC_BUF;
        const LAS float* EG = (const LAS float*)(L + SC_EG);
        f32x4 ks[4], qs[4];
#pragma unroll
        for (int mt = 0; mt < 4; ++mt) { ks[mt] = (f32x4){0.f, 0.f, 0.f, 0.f}; qs[mt] = (f32x4){0.f, 0.f, 0.f, 0.f}; }
#pragma unroll
        for (int s = 0; s < 4; ++s) { const bf16x8 bS = packB(S[2 * s], S[2 * s + 1]);
#pragma unroll
            for (int mt = 0; mt < 4; ++mt) {
                ks[mt] = __builtin_amdgcn_mfma_f32_16x16x32_bf16(ld_perm(L + SC_KN, 16 * mt + lr, 272, 32 * s, q), bS, ks[mt], 0, 0, 0);
                qs[mt] = __builtin_amdgcn_mfma_f32_16x16x32_bf16(ld_perm(L + SC_QN, 16 * mt + lr, 272, 32 * s, q), bS, qs[mt], 0, 0, 0); } }
        f32x4 R[4], eg[4];
#pragma unroll
        for (int mt = 0; mt < 4; ++mt) { eg[mt] = *(const LAS f32x4*)(EG + 16 * mt + 4 * q);
#pragma unroll
            for (int r = 0; r < 4; ++r) { const float vv = bf2f(*(const LAS bf16_t*)(L + SC_V + (16 * mt + 4 * q + r) * 272 + (cb + lr) * 2)); R[mt][r] = vv - eg[mt][r] * ks[mt][r]; } }
        f32x4 vn[4];
#pragma unroll
        for (int mt = 0; mt < 4; ++mt) vn[mt] = (f32x4){0.f, 0.f, 0.f, 0.f};
#pragma unroll
        for (int s = 0; s < 2; ++s) { const bf16x8 bR = packB(R[2 * s], R[2 * s + 1]);
#pragma unroll
            for (int mt = 2 * s; mt < 4; ++mt) vn[mt] = __builtin_amdgcn_mfma_f32_16x16x32_bf16(ld_perm(L + SC_TP, 16 * mt + lr, 144, 32 * s, q), bR, vn[mt], 0, 0, 0); }
#pragma unroll
        for (int mt = 0; mt < 4; ++mt) qs[mt] = qs[mt] * eg[mt];
#pragma unroll
        for (int s = 0; s < 2; ++s) { const bf16x8 bV = packB(vn[2 * s], vn[2 * s + 1]);
#pragma unroll
            for (int mt = 2 * s; mt < 4; ++mt) qs[mt] = __builtin_amdgcn_mfma_f32_16x16x32_bf16(ld_perm(L + SC_AI, 16 * mt + lr, 144, 32 * s, q), bV, qs[mt], 0, 0, 0); }
#pragma unroll
        for (int mt = 0; mt < 4; ++mt)
#pragma unroll
            for (int r = 0; r < 4; ++r) PA[(size_t)(b * SEQ + 64 * n + 16 * mt + 4 * q + r) * NPA + PA_QB + h * 128 + cb + lr] = f2bf(qs[mt][r]);
        const float dec = EG[128];
#pragma unroll
        for (int mt = 0; mt < 4; ++mt) { const f32x4 egl = *(const LAS f32x4*)(EG + 64 + 16 * mt + 4 * q); vn[mt] = vn[mt] * egl; }
#pragma unroll
        for (int tk = 0; tk < 8; ++tk) S[tk] = S[tk] * dec;
#pragma unroll
        for (int s = 0; s < 2; ++s) { const bf16x8 bW = packB(vn[2 * s], vn[2 * s + 1]);
#pragma unroll
            for (int tk = 0; tk < 8; ++tk) S[tk] = __builtin_amdgcn_mfma_f32_16x16x32_bf16(ld_perm_tr(L + SC_KN, 16 * tk, 32 * s, lr, q), bW, S[tk], 0, 0, 0); }
        SC_BARRIER();
    }
    float* so = C.out + O_DSTP + (size_t)bh * 128 * 128;
#pragma unroll
    for (int tk = 0; tk < 8; ++tk)
#pragma unroll
        for (int r = 0; r < 4; ++r) so[(16 * tk + 4 * q + r) * 128 + cb + lr] = S[tk][r];
}

template <int DH, int NT, bool BAND>
__device__ __forceinline__ void attn_wave(const LAS unsigned char* Kl, int KS, const LAS unsigned char* Vl, int VS, int tile0, const bf16_t* qrow,
                                          const LAS float* bias, int kmin, float scale, int lr, int q, f32x4 (&o)[DH / 16], float& mx_out, float& sum_out) {
    bf16x8 qf[DH / 32];
#pragma unroll
    for (int s = 0; s < DH / 32; ++s) qf[s] = *(const bf16x8*)(qrow + 32 * s + 8 * q);
    f32x4 sc[NT];
#pragma unroll
    for (int j = 0; j < NT; ++j) { sc[j] = (f32x4){0.f, 0.f, 0.f, 0.f};
#pragma unroll
        for (int s = 0; s < DH / 32; ++s) { const bf16x8 kf = *(const LAS bf16x8*)(Kl + (16 * (tile0 + j) + lr) * KS + (32 * s + 8 * q) * 2);
            sc[j] = __builtin_amdgcn_mfma_f32_16x16x32_bf16(kf, qf[s], sc[j], 0, 0, 0); }
        if (DH > 64) asm volatile("" ::: "memory"); }
    float mx = -INFINITY;
#pragma unroll
    for (int j = 0; j < NT; ++j)
#pragma unroll
        for (int r = 0; r < 4; ++r) { float sv = sc[j][r] * scale;
            if (BAND) { const int dist = 128 + lr - 16 * j - 4 * q - r; const int kidx = 16 * (tile0 + j) + 4 * q + r;
                const bool ok = (dist >= 0) && (dist <= 128) && (kidx >= kmin); const int dc = dist < 0 ? 0 : (dist > 128 ? 128 : dist);
                sv = ok ? sv + bias[dc] : -INFINITY; }
            sc[j][r] = sv; mx = fmaxf(mx, sv); }
    mx = fmaxf(mx, __shfl_xor(mx, 16)); mx = fmaxf(mx, __shfl_xor(mx, 32));
    float sum = 0.f;
#pragma unroll
    for (int j = 0; j < NT; ++j)
#pragma unroll
        for (int r = 0; r < 4; ++r) { const float p = __expf(sc[j][r] - mx); sc[j][r] = p; sum += p; }
    sum += __shfl_xor(sum, 16); sum += __shfl_xor(sum, 32);
#pragma unroll
    for (int mt = 0; mt < DH / 16; ++mt) o[mt] = (f32x4){0.f, 0.f, 0.f, 0.f};
#pragma unroll
    for (int i = 0; i < (NT + 1) / 2; ++i) {
        const bool two = (2 * i + 1 < NT);
        const f32x4 z4 = {0.f, 0.f, 0.f, 0.f};
        const bf16x8 pb = packB(sc[2 * i], two ? sc[(2 * i + 1 < NT) ? 2 * i + 1 : 2 * i] : z4);
#pragma unroll
        for (int mt = 0; mt < DH / 16; ++mt) {
            const u32x2 lo = *(const LAS u32x2*)(Vl + (16 * mt + lr) * VS + (16 * (tile0 + 2 * i) + 4 * q) * 2);
            u32x2 hi = {0u, 0u}; if (two) hi = *(const LAS u32x2*)(Vl + (16 * mt + lr) * VS + (16 * (tile0 + 2 * i + 1) + 4 * q) * 2);
            const u32x4 aw = {lo.x, lo.y, hi.x, hi.y};
            o[mt] = __builtin_amdgcn_mfma_f32_16x16x32_bf16(__builtin_bit_cast(bf16x8, aw), pb, o[mt], 0, 0, 0); }
        if (DH > 64) asm volatile("" ::: "memory"); }
    mx_out = mx; sum_out = sum;
}
constexpr int AT_K = 0;
constexpr int ATD_KS = 144, ATD_VS = 528, ATD_VT = 256 * ATD_KS, ATD_BIAS = ATD_VT + 64 * ATD_VS;
constexpr int ATC_KS = 272, ATC_VS = 528, ATC_VT = 256 * ATC_KS, ATC_END = ATC_VT + 128 * ATC_VS;
static_assert(ATC_END <= RING_BYTES && ATD_BIAS + 1024 <= RING_BYTES, "attention LDS");
template <int DH>
__device__ __forceinline__ void stage_kv(LAS unsigned char* Kl, int KS, LAS unsigned char* Vl, int VS, const bf16_t* kp, int voff, int key, int half) {
    constexpr int NP = DH / 16;
    u32x4 kv[NP], vv[NP];
#pragma unroll
    for (int i = 0; i < NP; ++i) { if (kp) { kv[i] = *(const u32x4*)(kp + half * (DH / 2) + 8 * i); vv[i] = *(const u32x4*)(kp + voff + half * (DH / 2) + 8 * i); } else { kv[i] = (u32x4){0u, 0u, 0u, 0u}; vv[i] = kv[i]; } }
#pragma unroll
    for (int i = 0; i < NP; ++i) { *(LAS u32x4*)(Kl + key * KS + (half * (DH / 2) + 8 * i) * 2) = kv[i];
#pragma unroll
        for (int e = 0; e < 8; ++e) { const unsigned wv = vv[i][e >> 1]; *(LAS bf16_t*)(Vl + (half * (DH / 2) + 8 * i + e) * VS + key * 2) = (bf16_t)((e & 1) ? (wv >> 16) : (wv & 0xffffu)); } }
}
template <bool DRY = false>
__device__ __forceinline__ void dil_attn_unit(CArgs* A, const Ctx& C, int u) {
    const int b = u / 192, rem = u % 192, gh = rem >> 4, sub = rem & 15, g = gh >> 2, h = gh & 3;
    const int dil = (g == 0) ? 1 : (g == 1 ? 4 : 16), nblk = 16 / dil, res = sub / nblk, qb = sub % nblk, i0 = 128 * qb;
    bf16_t* PA = wsp<bf16_t>(C, WS_R1); float* LSE = wsp<float>(C, WS_LSE);
    const int tid = C.tid, lane = C.lane, wave = C.wave, lr = lane & 15, q = lane >> 4;
    __syncthreads();
    { const int key = tid >> 1, half = tid & 1, kidx = i0 - 128 + key;
      const bf16_t* kp = (kidx >= 0) ? PA + (size_t)(b * SEQ + res + dil * kidx) * NPA + PA_KA + gh * 64 : nullptr;
      stage_kv<64>(C.lds + AT_K, ATD_KS, C.lds + ATD_VT, ATD_VS, kp, PA_VA - PA_KA, key, half);
      if (tid < 129) ((LAS float*)(C.lds + ATD_BIAS))[tid] = wsp<float>(C, WS_BIAS)[gh * 132 + tid]; }
    __syncthreads();
    const int tok = b * SEQ + res + dil * (i0 + 16 * wave + lr);
    bf16_t* qrow = PA + (size_t)tok * NPA + PA_QA + gh * 64;
    f32x4 o[4]; float mx, sum;
    attn_wave<64, 9, true>(C.lds + AT_K, ATD_KS, C.lds + ATD_VT, ATD_VS, wave, qrow, (const LAS float*)(C.lds + ATD_BIAS), 128 - i0, 0.125f, lr, q, o, mx, sum);
    const float inv = 1.f / sum;
    if (DRY) { if (sum == 12345.678f) LSE[0] = o[0][0] + o[1][1] + o[2][2] + o[3][3]; return; }
#pragma unroll
    for (int mt = 0; mt < 4; ++mt) { u32x2 w; w.x = cvt_pk_bf16(o[mt][0] * inv, o[mt][1] * inv); w.y = cvt_pk_bf16(o[mt][2] * inv, o[mt][3] * inv); *(u32x2*)(qrow + 16 * mt + 4 * q) = w; }
    if (q == 0) LSE[((size_t)g * MP + tok) * 4 + h] = mx + __logf(sum);
}
__device__ __forceinline__ void cross_attn_unit(CArgs* A, const Ctx& C, int u) {
    const int b = u >> 5, h = (u >> 3) & 3, sp = u & 7;
    const bf16_t* MKV = wsp<bf16_t>(C, WS_MEMKV); const bf16_t* QM = wsp<bf16_t>(C, WS_QM); bf16_t* OM = wsp<bf16_t>(C, WS_OM);
    const int tid = C.tid, lane = C.lane, wave = C.wave, lr = lane & 15, q = lane >> 4;
    __syncthreads();
    { const int key = tid >> 1, half = tid & 1; stage_kv<128>(C.lds + AT_K, ATC_KS, C.lds + ATC_VT, ATC_VS, MKV + (size_t)(b * 256 + key) * 1024 + h * 128, 512, key, half); }
    __syncthreads();
#pragma unroll 1
    for (int blk = 0; blk < 2; ++blk) {
        const int tok = b * SEQ + sp * 256 + blk * 128 + 16 * wave + lr;
        f32x4 o[8]; float mx, sum;
        attn_wave<128, 16, false>(C.lds + AT_K, ATC_KS, C.lds + ATC_VT, ATC_VS, 0, QM + (size_t)tok * 512 + h * 128, nullptr, 0, 0.08838834764831845f, lr, q, o, mx, sum);
        const float inv = 1.f / sum;
#pragma unroll
        for (int mt = 0; mt < 8; ++mt) { u32x2 w; w.x = cvt_pk_bf16(o[mt][0] * inv, o[mt][1] * inv); w.y = cvt_pk_bf16(o[mt][2] * inv, o[mt][3] * inv); *(u32x2*)(OM + (size_t)tok * 512 + h * 128 + 16 * mt + 4 * q) = w; }
    }
}

__device__ __forceinline__ void dil_sample_unit(CArgs* A, const Ctx& C, int u) {
    const int b = u >> 2, h = u & 3;
    const int tid = C.tid, lane = C.lane, wave = C.wave;
    const bf16_t* PA = wsp<bf16_t>(C, WS_R1); bf16_t* OA = wsp<bf16_t>(C, WS_OA); const float* BT = wsp<float>(C, WS_BIAS);
    LAS float* qs = (LAS float*)C.lds + wave * 64;
    LAS float* scb = (LAS float*)C.lds + 512 + wave * 192;
    LAS float* res = (LAS float*)C.lds + 2048;
    LAS float* lseb = (LAS float*)C.lds + 2048 + 768;
    __syncthreads();
    for (int task = wave; task < 12; task += 8) {
        const int g = task >> 2, t = task & 3, gh = g * 4 + h;
        const int dil = (g == 0) ? 1 : (g == 1 ? 4 : 16), L = 128 * dil;
        const float* cache = MK_IN(2 + g); const float* outc = C.out + (g == 0 ? O_DIL0S : (g == 1 ? O_DIL1S : O_DIL2S));
        qs[lane] = bf2f(PA[(size_t)(MP + b * 4 + t) * NPA + PA_QA + gh * 64 + lane]);
        LDS_WAIT();
        float sv[3]; float mx = -INFINITY;
#pragma unroll
        for (int pass = 0; pass < 3; ++pass) { const int jn = pass * 64 + lane; sv[pass] = -INFINITY;
            if (jn <= 128) { const int ci = L + t - dil * jn;
                const float* kr = (ci < L) ? cache + ((size_t)(b * L + ci) * 512 + h * 64) : outc + ((size_t)(b * L + L - 4 + (ci - L)) * 512 + h * 64);
                float acc = 0.f;
#pragma unroll
                for (int d4 = 0; d4 < 16; ++d4) { const f32x4 kv = *(const f32x4*)(kr + 4 * d4); const f32x4 qv = *(const LAS f32x4*)(qs + 4 * d4); acc += (kv[0] * qv[0] + kv[1] * qv[1]) + (kv[2] * qv[2] + kv[3] * qv[3]); }
                sv[pass] = acc * 0.125f + BT[gh * 132 + jn]; }
            mx = fmaxf(mx, sv[pass]); }
        mx = wave_max(mx);
        float sum = 0.f;
#pragma unroll
        for (int pass = 0; pass < 3; ++pass) { const int jn = pass * 64 + lane; const float p = (jn <= 128) ? __expf(sv[pass] - mx) : 0.f; sum += p; if (jn <= 128) scb[jn] = p; }
        sum = wave_sum(sum);
        LDS_WAIT();
        float acc = 0.f;
#pragma unroll 43
        for (int jn = 0; jn <= 128; ++jn) { const int ci = L + t - dil * jn;
            const float* vr = (ci < L) ? cache + ((size_t)(b * L + ci) * 512 + 256 + h * 64) : outc + ((size_t)(b * L + L - 4 + (ci - L)) * 512 + 256 + h * 64);
            acc += scb[jn] * vr[lane]; }
        res[task * 64 + lane] = acc / sum;
        if (lane == 0) lseb[task] = mx + __logf(sum);
    }
    __syncthreads();
    if (tid < 256) { const int t = tid >> 6, d = tid & 63;
        const float l0 = lseb[t], l1 = lseb[4 + t], l2 = lseb[8 + t]; const float m = fmaxf(l0, fmaxf(l1, l2));
        const float w0 = __expf(l0 - m), w1 = __expf(l1 - m), w2 = __expf(l2 - m);
        const float v = (w0 * res[t * 64 + d] + w1 * res[(4 + t) * 64 + d] + w2 * res[(8 + t) * 64 + d]) / (w0 + w1 + w2);
        OA[(size_t)(MP + b * 4 + t) * 256 + h * 64 + d] = f2bf(v); }
}
__device__ __forceinline__ void cross_sample_unit(CArgs* A, const Ctx& C, int u) {
    const int b = u >> 2, h = u & 3;
    const int tid = C.tid, lane = C.lane, wave = C.wave;
    const bf16_t* QM = wsp<bf16_t>(C, WS_QM); bf16_t* OM = wsp<bf16_t>(C, WS_OM);
    const float* ck = MK_IN(7); const float* cv = MK_IN(8);
    LAS float* qs = (LAS float*)C.lds + wave * 128;
    LAS float* scb = (LAS float*)C.lds + 1024 + wave * 128;
    LAS float* res = (LAS float*)C.lds + 2048;
    LAS float* ml = (LAS float*)C.lds + 3072;
    __syncthreads();
    const int t = wave & 3, half = wave >> 2;
    const bf16_t* qp = QM + (size_t)(MP + b * 4 + t) * 512 + h * 128;
    qs[lane] = bf2f(qp[lane]); qs[64 + lane] = bf2f(qp[64 + lane]);
    LDS_WAIT();
    float sv[2]; float mx = -INFINITY;
#pragma unroll
    for (int pass = 0; pass < 2; ++pass) { const int m = half * 128 + pass * 64 + lane; const float* kr = ck + ((size_t)(b * 256 + m) * 4 + h) * 128; float acc = 0.f;
#pragma unroll 8
        for (int d4 = 0; d4 < 32; ++d4) { const f32x4 kv = *(const f32x4*)(kr + 4 * d4); const f32x4 qv = *(const LAS f32x4*)(qs + 4 * d4); acc += (kv[0] * qv[0] + kv[1] * qv[1]) + (kv[2] * qv[2] + kv[3] * qv[3]); }
        sv[pass] = acc * 0.08838834764831845f; mx = fmaxf(mx, sv[pass]); }
    mx = wave_max(mx);
    float sum = 0.f;
#pragma unroll
    for (int pass = 0; pass < 2; ++pass) { const float p = __expf(sv[pass] - mx); sum += p; scb[pass * 64 + lane] = p; }
    sum = wave_sum(sum);
    LDS_WAIT();
    float a0 = 0.f, a1 = 0.f;
#pragma unroll 32
    for (int jn = 0; jn < 128; ++jn) { const float* vr = cv + ((size_t)(b * 256 + half * 128 + jn) * 4 + h) * 128; const float p = scb[jn]; a0 += p * vr[lane]; a1 += p * vr[64 + lane]; }
    res[wave * 128 + lane] = a0; res[wave * 128 + 64 + lane] = a1;
    if (lane == 0) { ml[wave * 2] = mx; ml[wave * 2 + 1] = sum; }
    __syncthreads();
    { const int tt = tid >> 7, d = tid & 127; const float m0 = ml[tt * 2], l0 = ml[tt * 2 + 1], m1 = ml[(tt + 4) * 2], l1 = ml[(tt + 4) * 2 + 1];
      const float m = fmaxf(m0, m1), e0 = __expf(m0 - m), e1 = __expf(m1 - m);
      OM[(size_t)(MP + b * 4 + tt) * 512 + h * 128 + d] = f2bf((res[tt * 128 + d] * e0 + res[(tt + 4) * 128 + d] * e1) / (l0 * e0 + l1 * e1)); }
}
__device__ __forceinline__ void gdn_sample_unit(CArgs* A, const Ctx& C, int u) {
    const int b = u >> 3, h = u & 7;
    const int tid = C.tid, lane = C.lane, wave = C.wave;
    const bf16_t* PA = wsp<bf16_t>(C, WS_R1); const bf16_t* PB = wsp<bf16_t>(C, WS_R2); bf16_t* OB = wsp<bf16_t>(C, WS_XN);
    LAS float* xs = (LAS float*)C.lds;
    LAS float* red = (LAS float*)C.lds + 1536;
    LAS float* osb = (LAS float*)C.lds + 2048;
    LAS float* sc8 = (LAS float*)C.lds + 2560;
    __syncthreads();
    if (tid < 384) { const int tensor = tid >> 7, ch = tid & 127, cidx = tensor * 1024 + h * 128 + ch;
        float xp[7];
#pragma unroll
        for (int i = 0; i < 3; ++i) xp[i] = MK_IN(6)[(size_t)(b * 3 + i) * 3072 + cidx];
#pragma unroll
        for (int t = 0; t < 4; ++t) xp[3 + t] = bf2f(PA[(size_t)(MP + b * 4 + t) * NPA + PA_QB + cidx]);
        float wv[4];
#pragma unroll
        for (int jj = 0; jj < 4; ++jj) wv[jj] = MK_IN(14)[jj * 3072 + cidx];
#pragma unroll
        for (int t = 0; t < 4; ++t) { float a = wv[0] * xp[t] + wv[1] * xp[t + 1] + wv[2] * xp[t + 2] + wv[3] * xp[t + 3]; xs[t * 384 + tid] = siluf_(a); } }
    __syncthreads();
    { const int tensor = wave >> 2, t = wave & 3; const float a = xs[t * 384 + tensor * 128 + lane], c = xs[t * 384 + tensor * 128 + 64 + lane];
      const float ss = wave_sum(a * a + c * c); if (lane == 0) sc8[wave] = rsqrtf(ss + EPS) * (tensor == 0 ? 0.08838834764831845f : 1.f); }
    __syncthreads();
    if (tid < 256) { const int tensor = tid >> 7;
#pragma unroll
        for (int t = 0; t < 4; ++t) xs[t * 384 + tid] *= sc8[tensor * 4 + t]; }
    const int v = tid & 127, kg = tid >> 7;
    float S[32];
    const float* s0 = MK_IN(5) + ((size_t)(b * 8 + h) * 128 + kg * 32) * 128 + v;
#pragma unroll
    for (int i = 0; i < 32; ++i) S[i] = s0[(size_t)i * 128];
    __syncthreads();
    float beta4[4], a4[4];
#pragma unroll
    for (int t = 0; t < 4; ++t) { const size_t row = (size_t)(MP + b * 4 + t);
        beta4[t] = sigmoidf_(bf2f(PB[row * NPB + PB_BETA + h])); const float xx = bf2f(PB[row * NPB + PB_A + h]) + MK_IN(16)[h];
        a4[t] = __expf(-__expf(MK_IN(15)[h]) * (fmaxf(xx, 0.f) + log1pf(__expf(-fabsf(xx))))); }
#pragma unroll
    for (int t = 0; t < 4; ++t) {
        const float beta = beta4[t], a = a4[t];
        const LAS float* kq = xs + t * 384;
        float part = 0.f;
#pragma unroll
        for (int i = 0; i < 32; ++i) part += kq[128 + kg * 32 + i] * S[i];
        red[kg * 128 + v] = part;
        __syncthreads();
        const float kS = red[v] + red[128 + v] + red[256 + v] + red[384 + v];
        const float uu = beta * (kq[256 + v] - a * kS);
        float po = 0.f;
#pragma unroll
        for (int i = 0; i < 32; ++i) { S[i] = a * S[i] + kq[128 + kg * 32 + i] * uu; po += kq[kg * 32 + i] * S[i]; }
        __syncthreads();
        red[kg * 128 + v] = po;
        __syncthreads();
        if (kg == 0) osb[t * 128 + v] = red[v] + red[128 + v] + red[256 + v] + red[384 + v];
        __syncthreads();
    }
    float* so = C.out + O_DSTS + ((size_t)(b * 8 + h) * 128 + kg * 32) * 128 + v;
#pragma unroll
    for (int i = 0; i < 32; ++i) so[(size_t)i * 128] = S[i];
    { const int t = tid >> 7; const float ov = osb[t * 128 + v]; float ss = wave_sum(ov * ov);
      if (lane == 0) red[wave] = ss;
      __syncthreads();
      const float tot = red[2 * t] + red[2 * t + 1]; const float rs = rsqrtf(tot * (1.f / 128.f) + EPS);
      const size_t row = (size_t)(MP + b * 4 + t);
      const float z = bf2f(PB[row * NPB + PB_Z + h * 128 + v]);
      OB[row * D + h * 128 + v] = f2bf(ov * rs * MK_IN(17)[v] * siluf_(z)); }
}

__device__ __forceinline__ void p4_merge(CArgs* A, const Ctx& C) {
    const bf16_t* PA = wsp<bf16_t>(C, WS_R1); const bf16_t* PB = wsp<bf16_t>(C, WS_R2); const float* LSE = wsp<float>(C, WS_LSE);
    bf16_t* OA = wsp<bf16_t>(C, WS_OA); bf16_t* OB = wsp<bf16_t>(C, WS_XN);
    const int lane = C.lane;
    for (int tok = C.gw; tok < MP; tok += C.NGW) {
        { const int col = 4 * lane, hh = col >> 6;
          const float l0 = LSE[((size_t)0 * MP + tok) * 4 + hh], l1 = LSE[((size_t)1 * MP + tok) * 4 + hh], l2 = LSE[((size_t)2 * MP + tok) * 4 + hh];
          const float m = fmaxf(l0, fmaxf(l1, l2)); float w0 = __expf(l0 - m), w1 = __expf(l1 - m), w2 = __expf(l2 - m); const float inv = 1.f / (w0 + w1 + w2); w0 *= inv; w1 *= inv; w2 *= inv;
          const u32x2 a0 = *(const u32x2*)(PA + (size_t)tok * NPA + col), a1 = *(const u32x2*)(PA + (size_t)tok * NPA + 256 + col), a2 = *(const u32x2*)(PA + (size_t)tok * NPA + 512 + col);
          u32x2 o; o.x = cvt_pk_bf16(w0 * bf_lo(a0.x) + w1 * bf_lo(a1.x) + w2 * bf_lo(a2.x), w0 * bf_hi(a0.x) + w1 * bf_hi(a1.x) + w2 * bf_hi(a2.x));
          o.y = cvt_pk_bf16(w0 * bf_lo(a0.y) + w1 * bf_lo(a1.y) + w2 * bf_lo(a2.y), w0 * bf_hi(a0.y) + w1 * bf_hi(a1.y) + w2 * bf_hi(a2.y));
          *(u32x2*)(OA + (size_t)tok * 256 + col) = o; }
        { const int col = 16 * lane;
          float ov[16], zv[16];
          { const u32x4 w0 = *(const u32x4*)(PA + (size_t)tok * NPA + PA_QB + col), w1 = *(const u32x4*)(PA + (size_t)tok * NPA + PA_QB + col + 8); float t0[8], t1[8]; unpack8(w0, t0); unpack8(w1, t1);
#pragma unroll
            for (int e = 0; e < 8; ++e) { ov[e] = t0[e]; ov[8 + e] = t1[e]; } }
          { const u32x4 w0 = *(const u32x4*)(PB + (size_t)tok * NPB + PB_Z + col), w1 = *(const u32x4*)(PB + (size_t)tok * NPB + PB_Z + col + 8); float t0[8], t1[8]; unpack8(w0, t0); unpack8(w1, t1);
#pragma unroll
            for (int e = 0; e < 8; ++e) { zv[e] = t0[e]; zv[8 + e] = t1[e]; } }
          float ss = 0.f;
#pragma unroll
          for (int e = 0; e < 16; ++e) ss += ov[e] * ov[e];
          ss += __shfl_xor(ss, 1); ss += __shfl_xor(ss, 2); ss += __shfl_xor(ss, 4);
          const float rs = rsqrtf(ss * (1.f / 128.f) + EPS);
          const float* gn = MK_IN(17) + (col & 127);
          float r[16];
#pragma unroll
          for (int e = 0; e < 16; ++e) r[e] = ov[e] * rs * gn[e] * siluf_(zv[e]);
          u32x4 o0, o1; o0.x = cvt_pk_bf16(r[0], r[1]); o0.y = cvt_pk_bf16(r[2], r[3]); o0.z = cvt_pk_bf16(r[4], r[5]); o0.w = cvt_pk_bf16(r[6], r[7]);
          o1.x = cvt_pk_bf16(r[8], r[9]); o1.y = cvt_pk_bf16(r[10], r[11]); o1.z = cvt_pk_bf16(r[12], r[13]); o1.w = cvt_pk_bf16(r[14], r[15]);
          *(u32x4*)(OB + (size_t)tok * D + col) = o0; *(u32x4*)(OB + (size_t)tok * D + col + 8) = o1; }
    }
}

__device__ __forceinline__ void p11_act(CArgs* A, const Ctx& C) {
    const bf16_t* GU = wsp<bf16_t>(C, WS_GU); bf16_t* ACT = wsp<bf16_t>(C, WS_ACT);
    const float* wc = MK_IN(28); const float* bc = MK_IN(29);
    constexpr int NCG = FF / 8;
    for (int it = C.gtid; it < (MP / 8) * NCG; it += C.NGT) { const int rb = it / NCG, cgp = it % NCG, c = cgp * 8, row0 = rb * 8; const bool first = (row0 % SEQ) == 0;
        float w0[8], w1[8], w2[8], bb[8];
#pragma unroll
        for (int e = 0; e < 8; ++e) { w0[e] = wc[c + e]; w1[e] = wc[FF + c + e]; w2[e] = wc[2 * FF + c + e]; bb[e] = bc[c + e]; }
        float g0[8], g1[8], g2[8];
        if (first) {
#pragma unroll
            for (int e = 0; e < 8; ++e) { g0[e] = 0.f; g1[e] = 0.f; } }
        else { unpack8(*(const u32x4*)(GU + (size_t)(row0 - 2) * NUP + c), g0); unpack8(*(const u32x4*)(GU + (size_t)(row0 - 1) * NUP + c), g1); }
#pragma unroll
        for (int r = 0; r < 8; ++r) { float up[8]; unpack8(*(const u32x4*)(GU + (size_t)(row0 + r) * NUP + c), g2); unpack8(*(const u32x4*)(GU + (size_t)(row0 + r) * NUP + FF + c), up);
            float o[8];
#pragma unroll
            for (int e = 0; e < 8; ++e) { const float a = w0[e] * g0[e] + w1[e] * g1[e] + w2[e] * g2[e] + bb[e]; o[e] = siluf_(a) * up[e]; g0[e] = g1[e]; g1[e] = g2[e]; }
            u32x4 w; w.x = cvt_pk_bf16(o[0], o[1]); w.y = cvt_pk_bf16(o[2], o[3]); w.z = cvt_pk_bf16(o[4], o[5]); w.w = cvt_pk_bf16(o[6], o[7]);
            *(u32x4*)(ACT + (size_t)(row0 + r) * FF + c) = w; } }
    for (int it = C.gtid; it < SB * NCG; it += C.NGT) { const int b = it / NCG, cgp = it % NCG, c = cgp * 8;
        float w0[8], w1[8], w2[8], bb[8], g0[8], g1[8], g2[8];
#pragma unroll
        for (int e = 0; e < 8; ++e) { w0[e] = wc[c + e]; w1[e] = wc[FF + c + e]; w2[e] = wc[2 * FF + c + e]; bb[e] = bc[c + e]; g0[e] = MK_IN(9)[(size_t)(b * 2) * FF + c + e]; g1[e] = MK_IN(9)[(size_t)(b * 2 + 1) * FF + c + e]; }
#pragma unroll
        for (int t = 0; t < 4; ++t) { const size_t row = (size_t)(MP + b * 4 + t); float up[8]; unpack8(*(const u32x4*)(GU + row * NUP + c), g2); unpack8(*(const u32x4*)(GU + row * NUP + FF + c), up);
            float o[8];
#pragma unroll
            for (int e = 0; e < 8; ++e) { const float a = w0[e] * g0[e] + w1[e] * g1[e] + w2[e] * g2[e] + bb[e]; o[e] = siluf_(a) * up[e]; g0[e] = g1[e]; g1[e] = g2[e]; }
            u32x4 w; w.x = cvt_pk_bf16(o[0], o[1]); w.y = cvt_pk_bf16(o[2], o[3]); w.z = cvt_pk_bf16(o[4], o[5]); w.w = cvt_pk_bf16(o[6], o[7]);
            *(u32x4*)(ACT + row * FF + c) = w; } }
    for (int it = C.gtid; it < NB * 2 * NCG; it += C.NGT) { const int bi = it / NCG, c = (it % NCG) * 8, b = bi >> 1, i = bi & 1; cp8(GU + (size_t)(b * SEQ + SEQ - 2 + i) * NUP + c, C.out + O_FCONVP + (size_t)bi * FF + c); }
    for (int it = C.gtid; it < SB * 2 * NCG; it += C.NGT) { const int bi = it / NCG, c = (it % NCG) * 8, b = bi >> 1, i = bi & 1; cp8(GU + (size_t)(MP + b * 4 + 2 + i) * NUP + c, C.out + O_FCONVS + (size_t)bi * FF + c); }
}
__device__ __forceinline__ void p13_final(CArgs* A, const Ctx& C) {
    const f32x4* gr = (const f32x4*)MK_IN(31) + C.lane;
    for (int m = C.gw; m < MV; m += C.NGW) { f32x4* xr = (f32x4*)(C.out + (size_t)m * D) + C.lane; f32x4 v[4]; float s = 0.f;
#pragma unroll
        for (int j = 0; j < 4; ++j) { v[j] = xr[64 * j]; s += (v[j].x * v[j].x + v[j].y * v[j].y) + (v[j].z * v[j].z + v[j].w * v[j].w); }
        const float rs = rsqrtf(wave_sum(s) * (1.f / D) + EPS);
#pragma unroll
        for (int j = 0; j < 4; ++j) xr[64 * j] = v[j] * rs * gr[64 * j]; }
}

#ifndef MK_REPEAT
#define MK_REPEAT -1
#endif
#ifndef MK_PER_PHASE
#define MK_PER_PHASE 0
#endif
constexpr int N_PHASES = 14;

#define PH_REFRESH0() do { A = (CArgs*)__builtin_amdgcn_kernarg_segment_ptr(); asm volatile("" : "+s"(A)); C.ws = A->ws; C.out = A->out; C.ctl = (unsigned*)C.ws; } while (0)
template <int ONLY> __global__ void __launch_bounds__(NTHR, 2) mk_fwd(Args args) {
    extern __shared__ __attribute__((aligned(16))) unsigned char lds_raw[];
    Ctx C;
    C.lds = (LAS unsigned char*)lds_raw; C.MISC = (volatile LAS unsigned*)(C.lds + MISC_OFF);
    C.tid = threadIdx.x; C.lane = C.tid & 63; C.wave = __builtin_amdgcn_readfirstlane(C.tid >> 6);
    C.G = gridDim.x; C.gw = blockIdx.x * NWAVES + C.wave; C.NGW = C.G * NWAVES; C.gtid = blockIdx.x * NTHR + C.tid; C.NGT = C.G * NTHR;
    CArgs* A; PH_REFRESH0();
    for (int u = C.tid; u < (LDS_BYTES - LDSCTL_OFF) / 4; u += NTHR) ((LAS unsigned*)(C.lds + LDSCTL_OFF))[u] = 0u;
    __syncthreads();
    XcdBarrier bar; bar.bar = C.ctl + CW_BAR; bar.x = 0; bar.st = nullptr;
    if (ONLY < 0) bar = xcd_barrier_post(C.ctl + CW_BAR, C.MISC + 8);
    const int lo = A->ph_lo, hi = A->ph_hi;
#define IN_PH(k) ((ONLY < 0 || ONLY == (k)) && lo <= (k) && (k) < hi)
#define SEAM(k) do { if (IN_PH(k) && IN_PH((k) + 1)) xcd_barrier(bar); } while (0)
    LAS unsigned char* ring = C.lds;
    const int bid = blockIdx.x;
#define PH_REFRESH() do { A = (CArgs*)__builtin_amdgcn_kernarg_segment_ptr(); asm volatile("" : "+s"(A)); C.ws = A->ws; C.out = A->out; C.ctl = (unsigned*)C.ws; } while (0)
#define XN_ wsp<bf16_t>(C, WS_XN)
#define PA_ wsp<bf16_t>(C, WS_R1)
#define PB_ wsp<bf16_t>(C, WS_R2)
#define HB_ wsp<bf16_t>(C, WS_HB)
#define T1_ wsp<bf16_t>(C, WS_T1)
#define SSQ1_ ((float*)(C.ws + WS_CTL + CTL_SSQ1))
#define SSQ2_ ((float*)(C.ws + WS_CTL + CTL_SSQ2))

    if (IN_PH(0)) { PH_REFRESH(); p0_prologue(A, C);
#if MK_REPEAT == 0
        xcd_barrier(bar); p0_prologue(A, C);
#endif
    } SEAM(0);
    if (IN_PH(1)) { PH_REFRESH();
        { pg8::Gemm g{XN_, wsp<bf16_t>(C, WS_WIN), MT, NIN, D}; pg8::StaticOrder S; S.init(MT, NIN, C.G, bid); EpiProj E{PA_, PB_};
          pg8::gemm_phase<EpiProj, pg8::StaticOrder, true, true>(ring, g, S, E); }
#if MK_REPEAT == 1
        xcd_barrier(bar);
        { pg8::Gemm g{XN_, wsp<bf16_t>(C, WS_WIN), MP, NIN, D}; pg8::StaticOrder S; S.init(MP, NIN, C.G, bid); EpiProj E{PA_, PB_};
          pg8::gemm_phase<EpiProj, pg8::StaticOrder, true, true>(ring, g, S, E); }
#elif MK_REPEAT == 101
        xcd_barrier(bar);
        { EpiProj E{PA_, PB_}; skinny_phase<false, D>(C, CW_Q2, XN_, wsp<bf16_t>(C, WS_WIN), NIN, E); }
#endif
        { pg8::Gemm g{wsp<bf16_t>(C, WS_MN), wsp<bf16_t>(C, WS_WMKV), 2048, D, D}; pg8::StaticOrder S; S.init(2048, D, C.G, (bid + 128) % C.G); EpiMemKV E{wsp<bf16_t>(C, WS_MEMKV), C.out + O_MEMKP, C.out + O_MEMVP};
          pg8::gemm_phase<EpiMemKV, pg8::StaticOrder, true, true>(ring, g, S, E); }
        copy_window(A, C, CW_SK0, 0, 200);
    } SEAM(1);
    if (IN_PH(2)) { PH_REFRESH(); for (int u = bid; u < 256; u += C.G) gdn_prep_unit(A, C, u); p2_state_copies(A, C);
#if MK_REPEAT == 2
        xcd_barrier(bar); for (int u = bid; u < 256; u += C.G) gdn_prep_unit(A, C, u);
#elif MK_REPEAT == 22
        xcd_barrier(bar); p2_state_copies(A, C);
#endif
    } SEAM(2);
    if (IN_PH(3)) { PH_REFRESH();
        for (int u = bid; u < 256; u += C.G) gdn_scan_unit(A, C, (u & 7) * 8 + (u >> 5), (u >> 3) & 3, u);
#if MK_REPEAT == 3
        for (int u = bid; u < 256; u += C.G) gdn_scan_unit(A, C, (u & 7) * 8 + (u >> 5), (u >> 3) & 3, u);
#endif
        for (;;) { const int u = next_unit(C, CW_Q0); if (u >= 128 + 256 + 1536) break;
            if (u < 128) dil_sample_unit(A, C, u); else if (u < 384) gdn_sample_unit(A, C, u - 128); else dil_attn_unit(A, C, u - 384); }
#if MK_REPEAT == 31
        xcd_barrier(bar);
        for (;;) { const int u = next_unit(C, CW_Q2); if (u >= 1536) break; dil_attn_unit<true>(A, C, u); }
#elif MK_REPEAT == 32
        xcd_barrier(bar);
        for (;;) { const int u = next_unit(C, CW_Q2); if (u >= 128 + 256) break; if (u < 128) dil_sample_unit(A, C, u); else gdn_sample_unit(A, C, u - 128); }
#endif
    } SEAM(3);
#if defined(MK_DUMP) && MK_DUMP == 3
    if (IN_PH(4)) {   PH_REFRESH();
#if MK_DUMPSEL == 16
        for (int i = C.gtid; i < MP * 128; i += C.NGT) { const int row = i >> 7, c = (i & 127) * 8; cp8(PA_ + (size_t)row * NPA + PA_QB + c, C.out + (size_t)row * D + c); }
#elif MK_DUMPSEL == 64
        for (int i = C.gtid; i < 2048 * 1024; i += C.NGT) { const int ch = i >> 10, p = i & 1023; cp8((const bf16_t*)(wsp<unsigned char>(C, WS_R3) + (size_t)ch * CH_STRIDE + 16384) + p * 8, C.out + (size_t)i * 8); }
#elif MK_DUMPSEL == 128
        for (int i = C.gtid; i < 2048 * 1024; i += C.NGT) { const int ch = i >> 10, p = i & 1023; cp8((const bf16_t*)(wsp<unsigned char>(C, WS_R3) + (size_t)ch * CH_STRIDE + 49152) + p * 8, C.out + (size_t)i * 8); }
#elif MK_DUMPSEL == 32
        for (int i = C.gtid; i < MP * 12; i += C.NGT) { const int row = i / 12, k = i % 12; C.out[(size_t)row * D + k] = wsp<float>(C, WS_LSE)[((size_t)(k >> 2) * MP + row) * 4 + (k & 3)]; }
#else
        for (int i = C.gtid; i < MV * 128; i += C.NGT) { const int row = i >> 7, c = (i & 127) * 8; const bf16_t* src;
            if (row < MP) src = (c < 768) ? PA_ + (size_t)row * NPA + c : PA_ + (size_t)row * NPA + PA_QB + (c - 768);
            else src = (c < 256) ? wsp<bf16_t>(C, WS_OA) + (size_t)row * 256 + c : XN_ + (size_t)row * D + (c - 256);
            const int sel = (row < MP) ? ((c < 768) ? 1 : 2) : ((c < 256) ? 4 : 8);
            if (sel & MK_DUMPSEL) cp8(src, C.out + (size_t)row * D + c); else { *(f32x4*)(C.out + (size_t)row * D + c) = (f32x4){0.f,0.f,0.f,0.f}; *(f32x4*)(C.out + (size_t)row * D + c + 4) = (f32x4){0.f,0.f,0.f,0.f}; } }
#endif
    }
#endif
    if (IN_PH(4)) { PH_REFRESH(); p4_merge(A, C);
#if MK_REPEAT == 4
        xcd_barrier(bar); p4_merge(A, C);
#endif
    } SEAM(4);
    if (IN_PH(5)) { PH_REFRESH();
        { pg8::Gemm g{wsp<bf16_t>(C, WS_OA), wsp<bf16_t>(C, WS_WA), MP, D, 256}; pg8::StaticOrder S; S.init(MP, D, C.G, bid); EpiBranch<false> E{T1_, PB_};
          pg8::gemm_phase<EpiBranch<false>, pg8::StaticOrder, true, true>(ring, g, S, E); }
        { pg8::Gemm g{XN_, wsp<bf16_t>(C, WS_WB), MP, D, D}; pg8::StaticOrder S; S.init(MP, D, C.G, bid); EpiBranch<true> E{T1_, PB_};
          pg8::gemm_phase<EpiBranch<true>, pg8::StaticOrder, true, true>(ring, g, S, E); }
        { EpiBranch<false> E{T1_, PB_}; skinny_phase<true, 256>(C, CW_SK0 + 64, wsp<bf16_t>(C, WS_OA), wsp<bf16_t>(C, WS_WA), D, E); }
        { EpiBranch<true> E{T1_, PB_}; skinny_phase<true, D>(C, CW_SK0 + 128, XN_, wsp<bf16_t>(C, WS_WB), D, E); }
    } SEAM(5);
    if (IN_PH(6)) { PH_REFRESH(); pg8::Gemm g{T1_, wsp<bf16_t>(C, WS_WOUT), MP, D, D}; pg8::StaticOrder S; S.init(MP, D, C.G, bid); EpiResid<true, false, true, true> E{A->in[0], A->in[1], C.out, HB_, SSQ1_};
        pg8::gemm_phase<EpiResid<true, false, true, true>, pg8::StaticOrder, true, true>(ring, g, S, E);
        skinny_phase<true, D>(C, CW_SK0 + 192, T1_, wsp<bf16_t>(C, WS_WOUT), D, E); } SEAM(6);
    if (IN_PH(7)) { PH_REFRESH(); pg8::Gemm g{HB_, wsp<bf16_t>(C, WS_WMQ), MT, 512, D}; pg8::StaticOrder S; S.init(MT, 512, C.G, bid); EpiScale E{wsp<bf16_t>(C, WS_QM), 512, SSQ1_};
        pg8::gemm_phase<EpiScale, pg8::StaticOrder, true, true>(ring, g, S, E);
        copy_window(A, C, CW_SK0 + 256, 200, 500); } SEAM(7);
    if (IN_PH(8)) { PH_REFRESH();
        { u32x4* z = (u32x4*)(wsp<bf16_t>(C, WS_OM) + (size_t)MV * 512); const int n16 = (MT - MV) * 512 * 2 / 16; for (int i = C.gtid; i < n16; i += C.NGT) z[i] = (u32x4){0u, 0u, 0u, 0u}; }
        for (;;) { const int u = next_unit(C, CW_Q1); if (u >= 256 + 128) break; if (u < 128) cross_sample_unit(A, C, u); else cross_attn_unit(A, C, u - 128); }
#if MK_REPEAT == 8
        xcd_barrier(bar);
        for (;;) { const int u = next_unit(C, CW_Q2); if (u >= 256 + 128) break; if (u < 256) cross_attn_unit(A, C, u); else cross_sample_unit(A, C, u - 256); }
#endif
    } SEAM(8);
    if (IN_PH(9)) { PH_REFRESH(); pg8::Gemm g{wsp<bf16_t>(C, WS_OM), wsp<bf16_t>(C, WS_WMO), MP, D, 512}; pg8::StaticOrder S; S.init(MP, D, C.G, bid); EpiResid<false, false, true, true> E{nullptr, nullptr, C.out, HB_, SSQ2_};
        pg8::gemm_phase<EpiResid<false, false, true, true>, pg8::StaticOrder, true, true>(ring, g, S, E);
        skinny_phase<true, 512>(C, CW_SK0 + 320, wsp<bf16_t>(C, WS_OM), wsp<bf16_t>(C, WS_WMO), D, E); } SEAM(9);
    if (IN_PH(10)) { PH_REFRESH(); pg8::Gemm g{HB_, wsp<bf16_t>(C, WS_WUP), MT, NUP, D}; pg8::StaticOrder S; S.init(MT, NUP, C.G, bid); EpiScale E{wsp<bf16_t>(C, WS_GU), NUP, SSQ2_};
        pg8::gemm_phase<EpiScale, pg8::StaticOrder, true, true>(ring, g, S, E);
        copy_window(A, C, CW_SK0 + 384, 500, CC_NCHUNK);
#if MK_REPEAT == 10
        xcd_barrier(bar);
        pg8::gemm_phase<EpiScale, pg8::StaticOrder, true, true>(ring, g, S, E);
#endif
    } SEAM(10);
    if (IN_PH(11)) { PH_REFRESH(); p11_act(A, C);
#if MK_REPEAT == 11
        xcd_barrier(bar); p11_act(A, C);
#endif
    } SEAM(11);
    if (IN_PH(12)) { PH_REFRESH(); pg8::Gemm g{wsp<bf16_t>(C, WS_ACT), wsp<bf16_t>(C, WS_WDN), MP, D, FF}; pg8::StaticOrder S; S.init(MP, D, C.G, bid); EpiResid<false, true, false, false> E{nullptr, nullptr, C.out, HB_, nullptr};
        pg8::gemm_phase<EpiResid<false, true, false, false>, pg8::StaticOrder, true, true>(ring, g, S, E);
        skinny_phase<true, FF>(C, CW_SK0 + 448, wsp<bf16_t>(C, WS_ACT), wsp<bf16_t>(C, WS_WDN), D, E); } SEAM(12);
    if (IN_PH(13)) { PH_REFRESH(); p13_final(A, C); }
#undef IN_PH
#undef SEAM
}
}


#ifndef MK_STOP_AFTER
#define MK_STOP_AFTER 13
#endif
#if MK_PER_PHASE
template <int P> static hipError_t set_lds_attr_p() { if (hipFuncSetAttribute((const void*)mk::mk_fwd<P>, hipFuncAttributeMaxDynamicSharedMemorySize, mk::LDS_BYTES) != hipSuccess) return hipErrorUnknown; if constexpr (P + 1 < mk::N_PHASES) return set_lds_attr_p<P + 1>(); else return hipSuccess; }
static hipError_t set_lds_attr() { return set_lds_attr_p<0>(); }
template <int P> static void launch_phases(mk::Args a, int grid, hipStream_t stream) { a.ph_lo = P; a.ph_hi = P + 1; a.li = 0; hipLaunchKernelGGL(mk::mk_fwd<P>, dim3(grid), dim3(mk::NTHR), mk::LDS_BYTES, stream, a); if constexpr (P + 1 < mk::N_PHASES && P + 1 <= MK_STOP_AFTER) launch_phases<P + 1>(a, grid, stream); }
#else
static hipError_t set_lds_attr() { return hipFuncSetAttribute((const void*)mk::mk_fwd<-1>, hipFuncAttributeMaxDynamicSharedMemorySize, mk::LDS_BYTES); }
#endif
extern "C" void kernel_launch(void* const* d_in, const int* in_sizes, int n_in, void* d_out, int out_size, void* d_ws, size_t ws_size, hipStream_t stream) {
    using namespace mk;
    static int grid = 0;
    if (grid == 0) {
        if (n_in != 32 || (size_t)out_size != O_END || ws_size < WS_END) { fprintf(stderr, "kernel_launch: unexpected problem: n_in %d out_size %d (want %zu) ws %zu (want >= %zu); nothing launched\n", n_in, out_size, (size_t)O_END, ws_size, (size_t)WS_END); grid = -1; return; }
        int dev = 0, cus = 0, per_cu = 0;
        if (hipGetDevice(&dev) != hipSuccess || hipDeviceGetAttribute(&cus, hipDeviceAttributeMultiprocessorCount, dev) != hipSuccess) { grid = -1; return; }
        if (set_lds_attr() != hipSuccess) { fprintf(stderr, "kernel_launch: hipFuncSetAttribute failed\n"); grid = -1; return; }
        if (hipOccupancyMaxActiveBlocksPerMultiprocessor(&per_cu, (const void*)mk_fwd<MK_PER_PHASE ? 1 : -1>, NTHR, LDS_BYTES) != hipSuccess || per_cu < 1) fprintf(stderr, "kernel_launch: occupancy query says %d blocks per CU\n", per_cu);
        (void)hipGetLastError();
        grid = cus;
    }
    if (grid < 0) return;
    if (hipMemsetAsync((char*)d_ws + WS_CTL, 0, CTL_ZERO_BYTES, stream) != hipSuccess) { fprintf(stderr, "kernel_launch: memset failed\n"); return; }
    Args a{};
    for (int i = 0; i < 32; ++i) a.in[i] = (const float*)d_in[i];
    a.out = (float*)d_out; a.ws = (unsigned char*)d_ws;
#if MK_PER_PHASE
    launch_phases<0>(a, grid, stream);
#else
    a.ph_lo = 0; a.ph_hi = N_PHASES; a.li = 0;
    hipLaunchKernelGGL(mk_fwd<-1>, dim3(grid), dim3(NTHR), LDS_BYTES, stream, a);
#endif
    const hipError_t le = hipPeekAtLastError();
    if (le != hipSuccess) fprintf(stderr, "kernel_launch: launch failed: %s\n", hipGetErrorName(le));
}
```
